# Optimizing an MI355X kernel written in HIP

```python
import math
import jax, jax.numpy as jnp
from jax import lax
import numpy as np

D_MODEL = 1024
BATCH = 4
SEQ = 8192
DEPTH = 2

N_EVEN = (DEPTH + 1) // 2
N_ODD = DEPTH // 2
ROPE_THETA = 10000.0
NORM_EPS = 1e-6
Q_BLOCK = 128

HG_W = D_MODEL // 2
HGRN_HEAD_DIM = 128
HGRN_HEADS = HG_W // HGRN_HEAD_DIM
HGRN_CHUNK = 64

MLA_NOPE_DIM = 128
MLA_ROPE_DIM = 64
MLA_V_DIM = 128
MLA_HEADS = (D_MODEL - HG_W) // MLA_V_DIM
MLA_Q_LORA = 3 * D_MODEL // 8
MLA_KV_LORA = D_MODEL // 4
MLA_QK_DIM = MLA_NOPE_DIM + MLA_ROPE_DIM
MLA_SCALE = MLA_QK_DIM ** -0.5

AB_SIZES = (HG_W,) * 5 + (MLA_Q_LORA, MLA_KV_LORA, MLA_ROPE_DIM)
AB_IN = sum(AB_SIZES)
AB_SPLITS = tuple(int(s) for s in np.cumsum(AB_SIZES)[:-1])
AB_MIX = HG_W + MLA_HEADS * MLA_V_DIM

DIFF_HEAD_DIM = 64
DIFF_HEADS = D_MODEL // (2 * DIFF_HEAD_DIM)
DIFF_SCALE = DIFF_HEAD_DIM ** -0.5
C_IN = 3 * D_MODEL

FFN_HIDDEN = ((8 * D_MODEL + 3 * 256 - 1) // (3 * 256)) * 256

kernel_name = 'hgrn2_mla_diffattn_hybrid_encoder'

F32 = jnp.float32


def rmsnorm(x, gain):
    xf = x.astype(F32)
    y = xf * lax.rsqrt(jnp.mean(xf * xf, axis=-1, keepdims=True) + NORM_EPS)
    return (y * gain.astype(F32)).astype(x.dtype)


def rope_tables(seq_len, dim):
    inv = 1.0 / (ROPE_THETA ** (jnp.arange(0, dim, 2, dtype=F32) / dim))
    ang = jnp.arange(seq_len, dtype=F32)[:, None] * inv[None, :]
    return jnp.cos(ang), jnp.sin(ang)


def apply_rope(x, cos, sin):
    shape = (1, x.shape[1]) + (1,) * (x.ndim - 3) + (cos.shape[-1],)
    c = cos.reshape(shape).astype(x.dtype)
    s = sin.reshape(shape).astype(x.dtype)
    x1, x2 = jnp.split(x, 2, axis=-1)
    return jnp.concatenate([x1 * c - x2 * s, x2 * c + x1 * s], axis=-1)


def sweep_query_blocks(fn, *qs):
    b, s = qs[0].shape[:2]
    nb = s // Q_BLOCK
    blocks = tuple(jnp.moveaxis(t.reshape((b, nb, Q_BLOCK) + t.shape[2:]), 1, 0) for t in qs)
    out = lax.map(lambda a: fn(*a), blocks)
    return jnp.moveaxis(out, 0, 1).reshape((b, s) + out.shape[3:])


def hgrn2_scan(q, k, v, log_f):
    b, s, h, dk = q.shape
    dv = v.shape[-1]
    L = HGRN_CHUNK
    nc = s // L

    def to_chunks(t):
        return t.reshape(b, nc, L, h, t.shape[-1]).transpose(1, 0, 3, 2, 4).astype(F32)

    incl = jnp.tril(jnp.ones((L, L), dtype=bool))[:, :, None]

    def step(state, inp):
        qc, kc, vc, gc = inp
        cum = jnp.cumsum(gc, axis=2)
        rel = jnp.exp(jnp.where(incl, cum[:, :, :, None, :] - cum[:, :, None, :, :], -jnp.inf))
        scores = jnp.einsum('bhtk,bhtsk,bhsk->bhts', qc, rel, kc)
        o = (jnp.einsum('bhts,bhsv->bhtv', scores, vc)
             + jnp.einsum('bhtk,bhkv->bhtv', qc * jnp.exp(cum), state))
        last = cum[:, :, -1:, :]
        state = (jnp.exp(last[:, :, 0, :, None]) * state
                 + jnp.einsum('bhsk,bhsv->bhkv', kc * jnp.exp(last - cum), vc))
        return state, o

    state0 = jnp.zeros((b, h, dk, dv), F32)
    _, o = lax.scan(step, state0, (to_chunks(q), to_chunks(k), to_chunks(v), to_chunks(log_f)))
    return o.transpose(1, 0, 3, 2, 4).reshape(b, s, h, dv).astype(v.dtype)


def hgrn2_mla_mixer(h, w_in, lb_fwd, lb_bwd, hgrn_norm, q_norm, w_uq, kv_norm, w_ukv, w_out, cos, sin):
    bsz, s, _ = h.shape
    z = h @ w_in
    q_h, f_fw, f_bw, i_h, g_h, cq, ckv, kr = jnp.split(z, AB_SPLITS, axis=-1)

    def heads(t):
        return t.reshape(bsz, s, HGRN_HEADS, HGRN_HEAD_DIM)

    q = heads(jax.nn.silu(q_h)) * (HGRN_HEAD_DIM ** -0.5)
    v = heads(i_h)

    def forget(f_pre, lb):
        fp = f_pre.astype(F32)
        log_f = jnp.log(lb + (1.0 - lb) * jax.nn.sigmoid(fp))
        k = (1.0 - lb) * jax.nn.sigmoid(-fp)
        return heads(k), heads(log_f)

    k_fw, lf_fw = forget(f_fw, lb_fwd)
    k_bw, lf_bw = forget(f_bw, lb_bwd)
    flip = lambda t: jnp.flip(t, axis=1)
    o_a = (hgrn2_scan(q, k_fw, v, lf_fw)
           + flip(hgrn2_scan(flip(q), flip(k_bw), flip(v), flip(lf_bw))))
    o_a = rmsnorm(o_a, hgrn_norm.reshape(HGRN_HEADS, HGRN_HEAD_DIM))
    o_a = o_a.reshape(bsz, s, HG_W) * jax.nn.silu(g_h)

    qf = (rmsnorm(cq, q_norm) @ w_uq).reshape(bsz, s, MLA_HEADS, MLA_QK_DIM)
    q_nope = qf[..., :MLA_NOPE_DIM]
    q_rope = apply_rope(qf[..., MLA_NOPE_DIM:], cos, sin)
    kvf = (rmsnorm(ckv, kv_norm) @ w_ukv).reshape(bsz, s, MLA_HEADS, MLA_NOPE_DIM + MLA_V_DIM)
    k_nope = kvf[..., :MLA_NOPE_DIM]
    v_b = kvf[..., MLA_NOPE_DIM:]
    k_rope = apply_rope(kr, cos, sin)

    def mla_block(qn, qr):
        sc = (jnp.einsum('bqhd,bkhd->bhqk', qn, k_nope)
              + jnp.einsum('bqhd,bkd->bhqk', qr, k_rope))
        p = jax.nn.softmax(sc.astype(F32) * MLA_SCALE, axis=-1)
        return jnp.einsum('bhqk,bkhd->bqhd', p.astype(v_b.dtype), v_b)

    o_b = sweep_query_blocks(mla_block, q_nope, q_rope).reshape(bsz, s, MLA_HEADS * MLA_V_DIM)

    return jnp.concatenate([o_a, o_b], axis=-1) @ w_out


def diff_attention_mixer(h, w_in, lq1, lk1, lq2, lk2, out_norm, w_out, lambda_init, cos, sin):
    bsz, s, _ = h.shape
    q, k, v = jnp.split(h @ w_in, 3, axis=-1)
    q = apply_rope(q.reshape(bsz, s, DIFF_HEADS, 2, DIFF_HEAD_DIM), cos, sin)
    k = apply_rope(k.reshape(bsz, s, DIFF_HEADS, 2, DIFF_HEAD_DIM), cos, sin)
    v = v.reshape(bsz, s, DIFF_HEADS, 2 * DIFF_HEAD_DIM)
    lam = (jnp.exp(jnp.sum(lq1.astype(F32) * lk1.astype(F32)))
           - jnp.exp(jnp.sum(lq2.astype(F32) * lk2.astype(F32))) + lambda_init)

    def diff_block(qb):
        sc = jnp.einsum('bqhcd,bkhcd->bhcqk', qb, k).astype(F32) * DIFF_SCALE
        p = jax.nn.softmax(sc, axis=-1)
        a = p[:, :, 0] - lam * p[:, :, 1]
        return jnp.einsum('bhqk,bkhd->bqhd', a.astype(v.dtype), v)

    o = sweep_query_blocks(diff_block, q)
    o = rmsnorm(o, out_norm) * (1.0 - lambda_init)
    return o.reshape(bsz, s, DIFF_HEADS * 2 * DIFF_HEAD_DIM) @ w_out


def swiglu(h, w_gate, w_up, w_down):
    return (jax.nn.silu(h @ w_gate) * (h @ w_up)) @ w_down


def setup_inputs(seed: int = 0) -> dict:
    key = jax.random.key(seed)
    ks = jax.random.split(key, 22)

    def w(i, shape, fan_in):
        return jax.random.normal(ks[i], shape, F32) * (fan_in ** -0.5)

    def gain(i, shape):
        return 1.0 + 0.02 * jax.random.normal(ks[i], shape, F32)

    return {
        'x': jax.random.normal(ks[0], (BATCH, SEQ, D_MODEL), F32),
        'norm_attn': gain(1, (DEPTH, D_MODEL)),
        'norm_ffn': gain(2, (DEPTH, D_MODEL)),
        'ffn_w_gate': w(3, (DEPTH, D_MODEL, FFN_HIDDEN), D_MODEL),
        'ffn_w_up': w(4, (DEPTH, D_MODEL, FFN_HIDDEN), D_MODEL),
        'ffn_w_down': w(5, (DEPTH, FFN_HIDDEN, D_MODEL), FFN_HIDDEN),
        'ab_w_in': w(6, (N_EVEN, D_MODEL, AB_IN), D_MODEL),
        'hgrn_lower_bound': 0.5 * jax.random.normal(ks[7], (2, N_EVEN + 1, HG_W), F32),
        'hgrn_out_norm': gain(8, (N_EVEN, HG_W)),
        'mla_q_norm': gain(9, (N_EVEN, MLA_Q_LORA)),
        'mla_w_uq': w(10, (N_EVEN, MLA_Q_LORA, MLA_HEADS * MLA_QK_DIM), MLA_Q_LORA),
        'mla_kv_norm': gain(11, (N_EVEN, MLA_KV_LORA)),
        'mla_w_ukv': w(12, (N_EVEN, MLA_KV_LORA, MLA_HEADS * (MLA_NOPE_DIM + MLA_V_DIM)), MLA_KV_LORA),
        'ab_w_out': w(13, (N_EVEN, AB_MIX, D_MODEL), AB_MIX),
        'c_w_in': w(14, (N_ODD, D_MODEL, C_IN), D_MODEL),
        'diff_lambda_q1': 0.1 * jax.random.normal(ks[15], (N_ODD, DIFF_HEAD_DIM), F32),
        'diff_lambda_k1': 0.1 * jax.random.normal(ks[16], (N_ODD, DIFF_HEAD_DIM), F32),
        'diff_lambda_q2': 0.1 * jax.random.normal(ks[17], (N_ODD, DIFF_HEAD_DIM), F32),
        'diff_lambda_k2': 0.1 * jax.random.normal(ks[18], (N_ODD, DIFF_HEAD_DIM), F32),
        'diff_out_norm': gain(19, (N_ODD, 2 * DIFF_HEAD_DIM)),
        'c_w_out': w(20, (N_ODD, D_MODEL, D_MODEL), D_MODEL),
        'final_norm': gain(21, (D_MODEL,)),
    }


def reference(x, norm_attn, norm_ffn, ffn_w_gate, ffn_w_up, ffn_w_down, ab_w_in, hgrn_lower_bound,
              hgrn_out_norm, mla_q_norm, mla_w_uq, mla_kv_norm, mla_w_ukv, ab_w_out, c_w_in,
              diff_lambda_q1, diff_lambda_k1, diff_lambda_q2, diff_lambda_k2, diff_out_norm,
              c_w_out, final_norm):
    seq_len = x.shape[1]
    cos_mla, sin_mla = rope_tables(seq_len, MLA_ROPE_DIM)
    cos_diff, sin_diff = rope_tables(seq_len, DIFF_HEAD_DIM)
    lower_bounds = jnp.cumsum(jax.nn.softmax(hgrn_lower_bound.astype(F32), axis=1), axis=1)

    for layer in range(DEPTH):
        j = layer // 2
        h = rmsnorm(x, norm_attn[layer])
        if layer % 2 == 0:
            mix = hgrn2_mla_mixer(h, ab_w_in[j], lower_bounds[0, j], lower_bounds[1, j],
                                  hgrn_out_norm[j], mla_q_norm[j], mla_w_uq[j], mla_kv_norm[j],
                                  mla_w_ukv[j], ab_w_out[j], cos_mla, sin_mla)
        else:
            lambda_init = 0.8 - 0.6 * math.exp(-0.3 * layer)
            mix = diff_attention_mixer(h, c_w_in[j], diff_lambda_q1[j], diff_lambda_k1[j],
                                       diff_lambda_q2[j], diff_lambda_k2[j], diff_out_norm[j],
                                       c_w_out[j], lambda_init, cos_diff, sin_diff)
        x = x + mix
        x = x + swiglu(rmsnorm(x, norm_ffn[layer]), ffn_w_gate[layer], ffn_w_up[layer], ffn_w_down[layer])
    return rmsnorm(x, final_norm)
```

```cpp
#include <hip/hip_runtime.h>
#include <hip/hip_cooperative_groups.h>
#include <cstdio>
#include <cstdint>
#include <cmath>
namespace cg = cooperative_groups;

typedef unsigned short bf16_t;
typedef short bf16x8 __attribute__((ext_vector_type(8)));
typedef short s16x4 __attribute__((ext_vector_type(4)));
typedef float f32x4 __attribute__((ext_vector_type(4)));
typedef float f32x16 __attribute__((ext_vector_type(16)));
typedef unsigned u32x4 __attribute__((ext_vector_type(4)));
typedef unsigned u32x2 __attribute__((ext_vector_type(2)));
#define DEV __device__ __forceinline__

constexpr int T_TOK = 32768, SEQ = 8192, NB = 4, DM = 1024, FH = 2816;
constexpr int ZLD = 3328;
constexpr int NTHR = 512;
constexpr float EPS = 1e-6f;
constexpr float LAMBDA_INIT = 0.35550906759096926f;

constexpr size_t al256(size_t x) { return (x + 255) / 256 * 256; }
constexpr size_t WS_WIN0 = 0;
constexpr size_t WS_WUQ = WS_WIN0 + al256((size_t)ZLD * 1024 * 2);
constexpr size_t WS_WUKV = WS_WUQ + al256((size_t)768 * 384 * 2);
constexpr size_t WS_WOUT0 = WS_WUKV + al256((size_t)1024 * 256 * 2);
constexpr size_t WS_WGU = WS_WOUT0 + al256((size_t)1024 * 1024 * 2);
constexpr size_t WS_WDN = WS_WGU + 2 * al256((size_t)5632 * 1024 * 2);
constexpr size_t WS_WCIN = WS_WDN + 2 * al256((size_t)1024 * 2816 * 2);
constexpr size_t WS_WCOUT = WS_WCIN + al256((size_t)3072 * 1024 * 2);
constexpr size_t WS_COS = WS_WCOUT + al256((size_t)1024 * 1024 * 2);
constexpr size_t WS_SIN = WS_COS + al256((size_t)8192 * 32 * 4);
constexpr size_t WS_HD = WS_SIN + al256((size_t)8192 * 32 * 4);
constexpr size_t WS_FLAG = WS_HD + al256((size_t)4096 * 128 * 4);
constexpr size_t WS_BAR = WS_FLAG + 4096;
constexpr size_t WS_HB = WS_BAR + 16384;
constexpr size_t WS_Z = WS_HB + al256((size_t)T_TOK * 1024 * 2);
constexpr size_t WS_CN = WS_Z + al256((size_t)T_TOK * ZLD * 2);
constexpr size_t WS_QF = WS_CN + al256((size_t)T_TOK * 640 * 2);
constexpr size_t WS_KVF = WS_QF + al256((size_t)T_TOK * 768 * 2);
constexpr size_t WS_END = WS_KVF + al256((size_t)T_TOK * 1024 * 2);
constexpr size_t WS_SCR = WS_CN;

constexpr int LDS_BYTES = 131072;

struct Params {
  const float* x; const float* norm_attn; const float* norm_ffn; const float* w_gate; const float* w_up; const float* w_down;
  const float* ab_w_in; const float* hg_lb; const float* hg_norm; const float* q_norm; const float* w_uq; const float* kv_norm;
  const float* w_ukv; const float* ab_w_out; const float* c_w_in; const float* lq1; const float* lk1; const float* lq2; const float* lk2;
  const float* diff_norm; const float* c_w_out; const float* final_norm;
  float* out; unsigned char* ws;
  float inv[32];
};

DEV float bf2f(bf16_t h) { return __uint_as_float(((unsigned)h) << 16); }
typedef float f32x2_t __attribute__((ext_vector_type(2))); typedef __bf16 bf16x2_t __attribute__((ext_vector_type(2)));
DEV unsigned cvtpk(float lo, float hi) { f32x2_t v = {lo, hi}; bf16x2_t b = __builtin_convertvector(v, bf16x2_t); return __builtin_bit_cast(unsigned, b); }
DEV bf16_t f2bf(float f) { return (bf16_t)(cvtpk(f, f) & 0xffffu); }
DEV float sigmoidf_(float x) { return __builtin_amdgcn_rcpf(1.f + __expf(-x)); }
DEV float siluf_(float x) { return x * __builtin_amdgcn_rcpf(1.f + __expf(-x)); }
DEV float shfl_xor_f(float v, int o) { int self = (int)__builtin_amdgcn_mbcnt_hi(~0u, __builtin_amdgcn_mbcnt_lo(~0u, 0u)); asm volatile("" : "+v"(self));
  return __int_as_float(__builtin_amdgcn_ds_bpermute((self ^ o) << 2, __float_as_int(v))); }
DEV int tidx() { int t = threadIdx.x; asm volatile("" : "+v"(t)); return t; }
DEV int vblock() { return (blockIdx.x & 7) * (gridDim.x >> 3) + (blockIdx.x >> 3); }

#define XB_TMO      128
#define XB_XCNT(j)  (256  + 64 * (j))
#define XB_XSUB(j)  (1280 + 64 * (j))
#define XB_XGEN(j)  (2304 + 64 * (j))
#define XB_TOP      3328
#define XB_TOPGEN   3392
#define XCD_BAR_WORDS 3456
#define XB_SPIN_CAP (1u << 18)
#define LAS __attribute__((address_space(3)))

__device__ __forceinline__ unsigned xb_ld(unsigned* p)              { return __hip_atomic_load(p, __ATOMIC_RELAXED, __HIP_MEMORY_SCOPE_AGENT); }
__device__ __forceinline__ unsigned xb_add(unsigned* p, unsigned v) { return __hip_atomic_fetch_add(p, v, __ATOMIC_RELAXED, __HIP_MEMORY_SCOPE_AGENT); }
__device__ __forceinline__ unsigned xb_xcc_id() { return (unsigned)__builtin_amdgcn_s_getreg((3 << 11) | 20) & 0xFu; }
#define XB_SPIN(cond, bar) do { unsigned _sp = 0; while (cond) { __builtin_amdgcn_s_sleep(1); \
    if ((++_sp & 255u) == 0u) { if (xb_ld(&(bar)[XB_TMO])) break; if (_sp > XB_SPIN_CAP) { atomicAdd(&(bar)[XB_TMO], 1u); break; } } } } while (0)

struct XcdBarrier {
    unsigned* bar; unsigned x;
    volatile LAS unsigned* st;
};

__device__ __forceinline__ XcdBarrier xcd_barrier_post(unsigned* bar, volatile LAS unsigned* st) {
    XcdBarrier b; b.bar = bar; b.x = xb_xcc_id(); b.st = st;
    if (threadIdx.x == 0) (void)xb_add(&bar[XB_XCNT(b.x)], 1u);
    return b;
}
__device__ __forceinline__ void xcd_barrier_complete(unsigned* bar, unsigned x, unsigned& nloc, unsigned& nx) {
    const unsigned G = gridDim.x * gridDim.y * gridDim.z;
    unsigned sum, cnt, mine, sp = 0u;
    for (;;) {
        sum = 0u; cnt = 0u; mine = 0u;
#pragma unroll
        for (unsigned j = 0; j < 16; ++j) { const unsigned c = xb_ld(&bar[XB_XCNT(j)]); sum += c; cnt += (c > 0u) ? 1u : 0u; mine = (j == x) ? c : mine; }
        if (sum == G) break;
        __builtin_amdgcn_s_sleep(1);
        if ((++sp & 255u) == 0u) { if (xb_ld(&bar[XB_TMO])) break; if (sp > XB_SPIN_CAP) { atomicAdd(&bar[XB_TMO], 1u); break; } }
    }
    nloc = mine > 0u ? mine : 1u; nx = cnt > 0u ? cnt : 1u;
}

__device__ __forceinline__ void xcd_barrier(const XcdBarrier& b) {
    asm volatile("s_waitcnt vmcnt(0)" ::: "memory");
    __syncthreads();
    if (threadIdx.x == 0) {
        unsigned* bar = b.bar;
        __builtin_amdgcn_s_waitcnt(0);
        unsigned nloc = b.st[0], nx = b.st[1];
        if (nloc == 0u) { xcd_barrier_complete(bar, b.x, nloc, nx); b.st[0] = nloc; b.st[1] = nx; }
        const unsigned old = xb_add(&bar[XB_XSUB(b.x)], 1u);
        const unsigned gen = old / nloc;
        if (old + 1u == (gen + 1u) * nloc) {
            __builtin_amdgcn_fence(__ATOMIC_RELEASE, "agent");
            asm volatile("s_waitcnt vmcnt(0)" ::: "memory");
            const unsigned og = xb_add(&bar[XB_TOP], 1u);
            const unsigned tg = og / nx;
            if (og + 1u == (tg + 1u) * nx) xb_add(&bar[XB_TOPGEN], 1u);
            else XB_SPIN(xb_ld(&bar[XB_TOPGEN]) == tg, bar);
            __builtin_amdgcn_fence(__ATOMIC_ACQUIRE, "agent");
            xb_add(&bar[XB_XGEN(b.x)], 1u);
            asm volatile("s_waitcnt vmcnt(0)" ::: "memory");
        } else {
            XB_SPIN(xb_ld(&bar[XB_XGEN(b.x)]) == gen, bar);
            __builtin_amdgcn_fence(__ATOMIC_ACQUIRE, "agent");
            asm volatile("s_waitcnt vmcnt(0)" ::: "memory");
        }
    }
    __syncthreads();
}


DEV void xpose_job(char* lds, const float* __restrict__ src, int K, int N, bf16_t* __restrict__ dst, int mode, int& rot) {
  float* tile = (float*)lds;
  const int nk = K >> 6, nn = (N + 255) >> 8, nt = nk * nn, tid = tidx();
  const int kr = tid >> 6, nl = tid & 63;
  int t0 = (int)blockIdx.x - rot; if (t0 < 0) t0 += gridDim.x;
  rot = (rot + nt) % (int)gridDim.x;
  for (int t = t0; t < nt; t += gridDim.x) {
    const int tk = t / nn, tn = t - tk * nn, k0 = tk * 64, n0 = tn * 256;
    float v[32];
#pragma unroll
    for (int c = 0; c < 4; ++c)
#pragma unroll
      for (int i = 0; i < 8; ++i) { const int gn = n0 + c * 64 + nl; v[c * 8 + i] = gn < N ? src[(size_t)(k0 + kr + 8 * i) * N + gn] : 0.f; }
    __syncthreads();
#pragma unroll
    for (int c = 0; c < 4; ++c)
#pragma unroll
      for (int i = 0; i < 8; ++i) tile[(kr + 8 * i) * 257 + c * 64 + nl] = v[c * 8 + i];
    __syncthreads();
#pragma unroll
    for (int j = 0; j < 16; ++j) {
      const int n = (tid >> 5) + 16 * j, kk = (tid & 31) * 2, gn = n0 + n;
      if (gn < N) { const int dn = mode == 0 ? gn : ((gn >> 4) * 32 + (gn & 15) + (mode == 2 ? 16 : 0));
        *(unsigned*)(dst + (size_t)dn * K + k0 + kk) = cvtpk(tile[kk * 257 + n], tile[(kk + 1) * 257 + n]); }
    }
  }
  __syncthreads();
}

DEV void rms_rows_bf16(const float* __restrict__ src, const float* __restrict__ gain, bf16_t* __restrict__ dst) {
  const int wid = tidx() >> 6, lane = tidx() & 63;
  f32x4 g[4];
#pragma unroll
  for (int i = 0; i < 4; ++i) g[i] = *(const f32x4*)(gain + lane * 4 + 256 * i);
  for (int row = blockIdx.x * 8 + wid; row < T_TOK; row += gridDim.x * 8) {
    const float* s = src + (size_t)row * DM; f32x4 v[4]; float ss = 0.f;
#pragma unroll
    for (int i = 0; i < 4; ++i) { v[i] = *(const f32x4*)(s + lane * 4 + 256 * i); ss += v[i][0] * v[i][0] + v[i][1] * v[i][1] + v[i][2] * v[i][2] + v[i][3] * v[i][3]; }
#pragma unroll
    for (int o = 32; o >= 1; o >>= 1) ss += shfl_xor_f(ss, o);
    const float r = rsqrtf(ss * (1.f / DM) + EPS);
#pragma unroll
    for (int i = 0; i < 4; ++i) { u32x2 w; w.x = cvtpk(v[i][0] * r * g[i][0], v[i][1] * r * g[i][1]); w.y = cvtpk(v[i][2] * r * g[i][2], v[i][3] * r * g[i][3]);
      *(u32x2*)(dst + (size_t)row * DM + lane * 4 + 256 * i) = w; }
  }
}
DEV void rms_rows_f32(float* __restrict__ buf, const float* __restrict__ gain) {
  const int wid = tidx() >> 6, lane = tidx() & 63;
  f32x4 g[4];
#pragma unroll
  for (int i = 0; i < 4; ++i) g[i] = *(const f32x4*)(gain + lane * 4 + 256 * i);
  for (int row = blockIdx.x * 8 + wid; row < T_TOK; row += gridDim.x * 8) {
    float* s = buf + (size_t)row * DM; f32x4 v[4]; float ss = 0.f;
#pragma unroll
    for (int i = 0; i < 4; ++i) { v[i] = *(const f32x4*)(s + lane * 4 + 256 * i); ss += v[i][0] * v[i][0] + v[i][1] * v[i][1] + v[i][2] * v[i][2] + v[i][3] * v[i][3]; }
#pragma unroll
    for (int o = 32; o >= 1; o >>= 1) ss += shfl_xor_f(ss, o);
    const float r = rsqrtf(ss * (1.f / DM) + EPS);
#pragma unroll
    for (int i = 0; i < 4; ++i) { f32x4 w = v[i] * r * g[i]; *(f32x4*)(s + lane * 4 + 256 * i) = w; }
  }
}
DEV void cnorm_rows(const bf16_t* __restrict__ z, const float* __restrict__ qg, const float* __restrict__ kg, bf16_t* __restrict__ cn) {
  const int wid = tidx() >> 6, lane = tidx() & 63;
  for (int row = blockIdx.x * 8 + wid; row < T_TOK; row += gridDim.x * 8) {
    const bf16_t* zr = z + (size_t)row * ZLD; float a[6], c[4]; float sa = 0.f, sc = 0.f;
#pragma unroll
    for (int i = 0; i < 6; ++i) { a[i] = bf2f(zr[2560 + lane + 64 * i]); sa += a[i] * a[i]; }
#pragma unroll
    for (int i = 0; i < 4; ++i) { c[i] = bf2f(zr[2944 + lane + 64 * i]); sc += c[i] * c[i]; }
#pragma unroll
    for (int o = 32; o >= 1; o >>= 1) { sa += shfl_xor_f(sa, o); sc += shfl_xor_f(sc, o); }
    const float ra = rsqrtf(sa * (1.f / 384.f) + EPS), rc = rsqrtf(sc * (1.f / 256.f) + EPS);
    bf16_t* o = cn + (size_t)row * 640;
#pragma unroll
    for (int i = 0; i < 6; ++i) o[lane + 64 * i] = f2bf(a[i] * ra * qg[lane + 64 * i]);
#pragma unroll
    for (int i = 0; i < 4; ++i) o[384 + lane + 64 * i] = f2bf(c[i] * rc * kg[lane + 64 * i]);
  }
}

constexpr int G_TILEB = 256 * 128, G_STAGEB = 2 * G_TILEB;

struct EpiStore {
  bf16_t* C; int ldc; int mode; const float* cs; const float* sn;
  DEV void operator()(f32x4 (&acc)[8][4], int row0, int col0, int fr, int fq) const {
    const int g = col0 >> 6; const bool rope = mode == 1 ? (g == 50) : mode == 2 ? (g % 3 == 2) : mode == 3 ? (g < 32) : false;
#pragma unroll
    for (int m = 0; m < 8; ++m) {
      const int row = row0 + m * 16 + fr;
      if (mode == 2) {
#pragma unroll
        for (int n = 0; n < 4; ++n) acc[m][n] = acc[m][n] * 0.10411754627697264f; }
      if (mode == 3 && col0 < 1024) {
#pragma unroll
        for (int n = 0; n < 4; ++n) acc[m][n] = acc[m][n] * 0.18033688011112042f; }
      if (rope) { const int pos = row & (SEQ - 1);
#pragma unroll
        for (int n = 0; n < 2; ++n) { const f32x4 c = *(const f32x4*)(cs + pos * 32 + n * 16 + 4 * fq), s = *(const f32x4*)(sn + pos * 32 + n * 16 + 4 * fq);
          const f32x4 x1 = acc[m][n], x2 = acc[m][n + 2]; acc[m][n] = x1 * c - x2 * s; acc[m][n + 2] = x2 * c + x1 * s; } }
#pragma unroll
      for (int n = 0; n < 4; ++n) { u32x2 w; w.x = cvtpk(acc[m][n][0], acc[m][n][1]); w.y = cvtpk(acc[m][n][2], acc[m][n][3]);
        *(u32x2*)(C + (size_t)row * ldc + col0 + n * 16 + 4 * fq) = w; }
    }
  }
};
struct EpiResid {
  const float* res; float* out;
  DEV void operator()(f32x4 (&acc)[8][4], int row0, int col0, int fr, int fq) const {
#pragma unroll
    for (int m = 0; m < 8; ++m) { const size_t ro = (size_t)(row0 + m * 16 + fr) * DM + col0 + 4 * fq;
#pragma unroll
      for (int n = 0; n < 4; ++n) { const f32x4 r = *(const f32x4*)(res + ro + n * 16); *(f32x4*)(out + ro + n * 16) = r + acc[m][n]; }
      if ((m & 3) == 3) asm volatile("" ::: "memory"); }
  }
};
struct EpiSwiglu {
  bf16_t* H;
  DEV void operator()(f32x4 (&acc)[8][4], int row0, int col0, int fr, int fq) const {
#pragma unroll
    for (int m = 0; m < 8; ++m) { bf16_t* hp = H + (size_t)(row0 + m * 16 + fr) * FH + (col0 >> 1) + 4 * fq;
#pragma unroll
      for (int i = 0; i < 2; ++i) { const f32x4 g = acc[m][2 * i], u = acc[m][2 * i + 1]; u32x2 w;
        w.x = cvtpk(siluf_(g[0]) * u[0], siluf_(g[1]) * u[1]); w.y = cvtpk(siluf_(g[2]) * u[2], siluf_(g[3]) * u[3]); *(u32x2*)(hp + i * 16) = w; } }
  }
};

template <class Epi, bool PF = true>
DEV void gemm_phase(char* lds, const bf16_t* __restrict__ A, int lda, const bf16_t* __restrict__ Bt, int ldb, int K, int nN, int nTiles, const Epi& E) {
  const int tid = tidx(), wid = tid >> 6, lane = tid & 63, wr = wid >> 2, wc = wid & 3, fr = lane & 15, fq = lane >> 4;
  const int nk = K >> 6, lrow = tid >> 3, lkc = tid & 7;
  const int hw = (((lrow >> 1) & 1) << 1) | (((lrow >> 3) & 1) << 2), hr = (((fr >> 1) & 1) << 1) | (((fr >> 3) & 1) << 2);
  const unsigned wofs = lrow * 128 + ((lkc ^ hw) << 4);
  const unsigned aofs0 = (wr * 128 + fr) * 128 + ((fq ^ hr) << 4), aofs1 = (wr * 128 + fr) * 128 + (((4 + fq) ^ hr) << 4);
  const unsigned bofs0 = G_TILEB + (wc * 64 + fr) * 128 + ((fq ^ hr) << 4), bofs1 = G_TILEB + (wc * 64 + fr) * 128 + (((4 + fq) ^ hr) << 4);
  const unsigned ao = (unsigned)(lrow * lda + lkc * 8) * 2u, bo = (unsigned)(lrow * ldb + lkc * 8) * 2u;
  const unsigned as64 = (unsigned)(64 * lda) * 2u, bs64 = (unsigned)(64 * ldb) * 2u;
  typedef __attribute__((address_space(3))) unsigned lds_u32;
  const unsigned gao = (unsigned)(lrow * lda + ((lkc ^ hw) << 3)) * 2u, gbo = (unsigned)(lrow * ldb + ((lkc ^ hw) << 3)) * 2u;
  const unsigned ldsw = (unsigned)wid * 1024u;
#define G_DMA(stg, k0) do { _Pragma("unroll") for (int i = 0; i < 4; ++i) { \
      __builtin_amdgcn_global_load_lds((const unsigned*)(Ab + (k0) * 2 + gao + i * as64), (lds_u32*)(lds + (stg) * G_STAGEB + ldsw + i * 8192), 16, 0, 0); \
      __builtin_amdgcn_global_load_lds((const unsigned*)(Bb + (k0) * 2 + gbo + i * bs64), (lds_u32*)(lds + (stg) * G_STAGEB + G_TILEB + ldsw + i * 8192), 16, 0, 0); } } while (0)
#define G_HALF(AO, BO, M0) do { _Pragma("unroll") for (int m = 0; m < 4; ++m) af[m] = *(const bf16x8*)(cur + (AO) + ((M0) + m) * 2048); \
      _Pragma("unroll") for (int m = 0; m < 4; ++m) _Pragma("unroll") for (int n = 0; n < 4; ++n) acc[(M0) + m][n] = __builtin_amdgcn_mfma_f32_16x16x32_bf16(bfr[n], af[m], acc[(M0) + m][n], 0, 0, 0); } while (0)
  for (int t = vblock(); t < nTiles; t += gridDim.x) {
    const int pm = t / nN, pn = t - pm * nN;
    const char* Ab = (const char*)(A + (size_t)pm * 256 * lda);
    const char* Bb = (const char*)(Bt + (size_t)pn * 256 * ldb);
    f32x4 acc[8][4];
#pragma unroll
    for (int m = 0; m < 8; ++m)
#pragma unroll
      for (int n = 0; n < 4; ++n) acc[m][n] = (f32x4){0.f, 0.f, 0.f, 0.f};
    __syncthreads();
    G_DMA(0, 0);
    asm volatile("s_waitcnt vmcnt(0)" ::: "memory");
    __syncthreads();
    for (int kt = 0; kt < nk; ++kt) {
      const char* cur = lds + (kt & 1) * G_STAGEB;
      if (kt + 1 < nk) G_DMA((kt & 1) ^ 1, (kt + 1) * 64);
      bf16x8 bfr[4], af[4];
#pragma unroll
      for (int n = 0; n < 4; ++n) bfr[n] = *(const bf16x8*)(cur + bofs0 + n * 2048);
#pragma unroll
      for (int m = 0; m < 4; ++m) af[m] = *(const bf16x8*)(cur + aofs0 + m * 2048);
#pragma unroll
      for (int m = 0; m < 4; ++m)
#pragma unroll
        for (int n = 0; n < 4; ++n) acc[m][n] = __builtin_amdgcn_mfma_f32_16x16x32_bf16(bfr[n], af[m], acc[m][n], 0, 0, 0);
      G_HALF(aofs0, bofs0, 4);
#pragma unroll
      for (int n = 0; n < 4; ++n) bfr[n] = *(const bf16x8*)(cur + bofs1 + n * 2048);
      G_HALF(aofs1, bofs1, 0);
      G_HALF(aofs1, bofs1, 4);
      asm volatile("s_waitcnt vmcnt(0)" ::: "memory");
      __syncthreads();
    }
    E(acc, pm * 256 + wr * 128, pn * 256 + wc * 64, fr, fq);
  }
#undef G_DMA
#undef G_HALF
}

#define SBAR() __builtin_amdgcn_sched_barrier(0)
DEV int crow(int r, int hi) { return (r & 3) + 8 * (r >> 2) + 4 * hi; }
constexpr float ATT_THR = 8.f;
template <int NQK> struct AttnK {
  static constexpr int DQK = NQK * 16, KROWB = DQK * 2, SHM_K = 64 * KROWB, SHM_V = 64 * 128 * 2, SHM = 2 * SHM_V + 2 * SHM_K + 8 * 64 * 4;
  static constexpr float SCALE = NQK == 12 ? 0.07216878364870323f : 0.125f;
  static constexpr int TAILC = NQK == 12 ? 128 : 0;
};
template <int NQK> DEV void partialSM(f32x16& p0, f32x16& p1, float& m_reg, float& mn, float& alpha) {
  constexpr float SC = AttnK<NQK>::SCALE, C = SC * 1.4426950408889634f;
  float pmax = p0[0];
#pragma unroll
  for (int r = 1; r < 16; ++r) pmax = fmaxf(pmax, p0[r]);
#pragma unroll
  for (int r = 0; r < 16; ++r) pmax = fmaxf(pmax, p1[r]);
  { auto rr = __builtin_amdgcn_permlane32_swap(__float_as_uint(pmax), __float_as_uint(pmax), false, false);
    pmax = fmaxf(__uint_as_float(rr[0]), __uint_as_float(rr[1])); }
  if (__builtin_expect(__all(pmax - m_reg <= ATT_THR / SC), 1)) { mn = m_reg; alpha = 1.f; }
  else { mn = fmaxf(m_reg, pmax); alpha = __builtin_amdgcn_exp2f((m_reg - mn) * C); m_reg = mn; }
  const float mnC = -mn * C;
#pragma unroll
  for (int r = 0; r < 16; ++r) p0[r] = fmaf(p0[r], C, mnC);
#pragma unroll
  for (int r = 0; r < 16; ++r) p1[r] = fmaf(p1[r], C, mnC);
#pragma unroll
  for (int r = 0; r < 16; ++r) p0[r] = __builtin_amdgcn_exp2f(p0[r]);
}
DEV void finishSM(f32x16& p0, f32x16& p1, float alpha, float& l_reg, bf16x8& pa0, bf16x8& pa1, bf16x8& pa2, bf16x8& pa3) {
#pragma unroll
  for (int r = 0; r < 16; ++r) p1[r] = __builtin_amdgcn_exp2f(p1[r]);
  float ps = 0;
#pragma unroll
  for (int r = 0; r < 16; ++r) ps += p0[r];
#pragma unroll
  for (int r = 0; r < 16; ++r) ps += p1[r];
  { auto rr = __builtin_amdgcn_permlane32_swap(__float_as_uint(ps), __float_as_uint(ps), false, false);
    ps = __uint_as_float(rr[0]) + __uint_as_float(rr[1]); }
  l_reg = l_reg * alpha + ps;
#define PK4(P, BASE, OUT) do { unsigned a0 = cvtpk(P[BASE + 0], P[BASE + 1]), a1 = cvtpk(P[BASE + 2], P[BASE + 3]);   \
    unsigned b0 = cvtpk(P[BASE + 4], P[BASE + 5]), b1 = cvtpk(P[BASE + 6], P[BASE + 7]);                              \
    auto r0 = __builtin_amdgcn_permlane32_swap(a0, b0, false, false); auto r1 = __builtin_amdgcn_permlane32_swap(a1, b1, false, false); \
    u32x4 w = {r0[0], r1[0], r0[1], r1[1]}; OUT = *reinterpret_cast<bf16x8*>(&w); } while (0)
  PK4(p0, 0, pa0); PK4(p0, 8, pa1); PK4(p1, 0, pa2); PK4(p1, 8, pa3);
#undef PK4
}
template <int NQK> DEV void qkt(f32x16& p0, f32x16& p1, const char* Ks, const bf16x8* qr, int r32, int hi) {
  constexpr int KROWB = AttnK<NQK>::KROWB;
  p0 = f32x16{}; p1 = f32x16{};
#pragma unroll
  for (int d0 = 0; d0 < NQK; ++d0) { const int cb = (d0 * 16 + hi * 8) * 2;
    const bf16x8 b0 = *reinterpret_cast<const bf16x8*>(Ks + r32 * KROWB + (cb ^ ((r32 & 7) << 4)));
    const bf16x8 b1 = *reinterpret_cast<const bf16x8*>(Ks + (32 + r32) * KROWB + (cb ^ ((r32 & 7) << 4)));
    p0 = __builtin_amdgcn_mfma_f32_32x32x16_bf16(b0, qr[d0], p0, 0, 0, 0);
    p1 = __builtin_amdgcn_mfma_f32_32x32x16_bf16(b1, qr[d0], p1, 0, 0, 0); }
}
DEV int v_st(int k, int c) { const int kk = (k & ~0xC) | ((k & 4) << 1) | ((k & 8) >> 1); return ((kk >> 3) * 4 + (c >> 5)) * 512 + ((kk & 7) * 32 + (c & 31)) * 2; }
DEV int v_rd_base(int lane) { return ((lane & 3) << 3) | (((lane >> 2) & 3) << 6) | (((lane >> 4) & 1) << 5) | (((lane >> 5) & 1) << 8); }
constexpr int v_rd_off(int d0, int ks, int half) { return d0 * 512 + ks * 4096 + half * 2048; }
template <int OFF> DEV s16x4 tr_read(int vb) { s16x4 r; asm volatile("ds_read_b64_tr_b16 %0, %1 offset:%2" : "=&v"(r) : "v"(vb), "i"(OFF) : "memory"); return r; }
template <int D0> DEV void pv_one(f32x16& od, int vb, bf16x8 pa0, bf16x8 pa1, bf16x8 pa2, bf16x8 pa3) {
  const s16x4 l0 = tr_read<v_rd_off(D0, 0, 0)>(vb), h0 = tr_read<v_rd_off(D0, 0, 1)>(vb), l1 = tr_read<v_rd_off(D0, 1, 0)>(vb), h1 = tr_read<v_rd_off(D0, 1, 1)>(vb);
  const s16x4 l2 = tr_read<v_rd_off(D0, 2, 0)>(vb), h2 = tr_read<v_rd_off(D0, 2, 1)>(vb), l3 = tr_read<v_rd_off(D0, 3, 0)>(vb), h3 = tr_read<v_rd_off(D0, 3, 1)>(vb);
  asm volatile("s_waitcnt lgkmcnt(0)" ::: "memory"); SBAR();
#define PKV(L, H) (bf16x8){L[0], L[1], L[2], L[3], H[0], H[1], H[2], H[3]}
  od = __builtin_amdgcn_mfma_f32_32x32x16_bf16(pa0, PKV(l0, h0), od, 0, 0, 0);
  od = __builtin_amdgcn_mfma_f32_32x32x16_bf16(pa1, PKV(l1, h1), od, 0, 0, 0);
  od = __builtin_amdgcn_mfma_f32_32x32x16_bf16(pa2, PKV(l2, h2), od, 0, 0, 0);
  od = __builtin_amdgcn_mfma_f32_32x32x16_bf16(pa3, PKV(l3, h3), od, 0, 0, 0);
#undef PKV
}
DEV void pv_d0(f32x16* o, int vb, bf16x8 pa0, bf16x8 pa1, bf16x8 pa2, bf16x8 pa3) {
  pv_one<0>(o[0], vb, pa0, pa1, pa2, pa3); pv_one<1>(o[1], vb, pa0, pa1, pa2, pa3); pv_one<2>(o[2], vb, pa0, pa1, pa2, pa3); pv_one<3>(o[3], vb, pa0, pa1, pa2, pa3);
}

template <int NQK> DEV void qkt_pre(f32x16& p0, f32x16& p1, const char* Ks, const bf16x8* qr, int r32, int hi, float m_reg) {
  constexpr int KROWB = AttnK<NQK>::KROWB;
  f32x16 nm;
#pragma unroll
  for (int r = 0; r < 16; ++r) nm[r] = -m_reg;
#pragma unroll
  for (int d0 = 0; d0 < NQK; ++d0) { const int cb = (d0 * 16 + hi * 8) * 2;
    const bf16x8 b0 = *reinterpret_cast<const bf16x8*>(Ks + r32 * KROWB + (cb ^ ((r32 & 7) << 4)));
    const bf16x8 b1 = *reinterpret_cast<const bf16x8*>(Ks + (32 + r32) * KROWB + (cb ^ ((r32 & 7) << 4)));
    p0 = __builtin_amdgcn_mfma_f32_32x32x16_bf16(b0, qr[d0], d0 == 0 ? nm : p0, 0, 0, 0);
    p1 = __builtin_amdgcn_mfma_f32_32x32x16_bf16(b1, qr[d0], d0 == 0 ? nm : p1, 0, 0, 0); }
}
DEV void partialSM_pre(f32x16& p0, f32x16& p1, float& m_reg, float& alpha, bool first) {
  constexpr float THRL = ATT_THR * 1.4426950408889634f;
  float pmax = p0[0];
#pragma unroll
  for (int r = 1; r < 16; ++r) pmax = fmaxf(pmax, p0[r]);
#pragma unroll
  for (int r = 0; r < 16; ++r) pmax = fmaxf(pmax, p1[r]);
  { auto rr = __builtin_amdgcn_permlane32_swap(__float_as_uint(pmax), __float_as_uint(pmax), false, false);
    pmax = fmaxf(__uint_as_float(rr[0]), __uint_as_float(rr[1])); }
  if (__builtin_expect(!first && __all(pmax <= THRL), 1)) { alpha = 1.f; }
  else { const float delta = first ? pmax : fmaxf(pmax, 0.f); alpha = first ? 1.f : __builtin_amdgcn_exp2f(-delta); m_reg += delta;
#pragma unroll
    for (int r = 0; r < 16; ++r) p0[r] -= delta;
#pragma unroll
    for (int r = 0; r < 16; ++r) p1[r] -= delta; }
#pragma unroll
  for (int r = 0; r < 16; ++r) p0[r] = __builtin_amdgcn_exp2f(p0[r]);
}
template <int NQK, bool PRE = false>
DEV void attn_body(const bf16_t* __restrict__ Qb, int ldq, const bf16_t* __restrict__ Kn, int ldkn, const bf16_t* __restrict__ Kt, int ldkt,
                   const bf16_t* __restrict__ Vh, int ldv, int seq, char* lds, f32x16 (&o)[4]) {
  typedef AttnK<NQK> CF;
  constexpr int SHM_V = CF::SHM_V, SHM_K = CF::SHM_K, KROWB = CF::KROWB, TAILC = CF::TAILC;
  const int tid = tidx(), wid = tid >> 6, lane = tid & 63, r32 = lane & 31, hi = lane >> 5;
  char* V_lds = lds; char* K_lds = lds + 2 * SHM_V;
  float* wsl = (float*)(lds + 2 * SHM_V + 2 * SHM_K) + wid * 64; float* li_l = wsl; float* al_l = wsl + 32;
  float m_reg = PRE ? 0.f : -1e30f, l_reg = 0;
#pragma unroll
  for (int d = 0; d < 4; ++d) o[d] = f32x16{};
  bf16x8 qr[NQK];
  const bf16_t* Qw = Qb + (size_t)(wid * 32 + r32) * ldq + hi * 8;
#pragma unroll
  for (int d0 = 0; d0 < NQK; ++d0) qr[d0] = *(const bf16x8*)(Qw + d0 * 16);
  const int sr = tid >> 4, sc = (tid & 15) * 8, vst0 = v_st(sr, sc), vst1 = v_st(32 + sr, sc);
  const int tr = tid >> 3, tc = (tid & 7) * 8;
  const int kst0 = sr * KROWB + ((sc * 2) ^ ((sr & 7) << 4)), kst1 = (32 + sr) * KROWB + ((sc * 2) ^ ((sr & 7) << 4));
  const int kstt = tr * KROWB + (((TAILC + tc) * 2) ^ ((tr & 7) << 4));
  const int vb0 = (int)(uintptr_t)V_lds + v_rd_base(lane);
  bf16x8 sv0[2], sv1[2], sk0[2], sk1[2], skt[2];
#define SLOAD(i, k0) do { sv0[i] = *(const bf16x8*)(Vh + (size_t)((k0) + sr) * ldv + sc); sv1[i] = *(const bf16x8*)(Vh + (size_t)((k0) + 32 + sr) * ldv + sc); \
    if (NQK == 12) { sk0[i] = *(const bf16x8*)(Kn + (size_t)((k0) + sr) * ldkn + sc); sk1[i] = *(const bf16x8*)(Kn + (size_t)((k0) + 32 + sr) * ldkn + sc); } \
    skt[i] = *(const bf16x8*)(Kt + (size_t)((k0) + tr) * ldkt + tc); } while (0)
#define SWRITE(b, i) do { *(bf16x8*)(V_lds + (b) * SHM_V + vst0) = sv0[i]; *(bf16x8*)(V_lds + (b) * SHM_V + vst1) = sv1[i]; \
    if (NQK == 12) { *(bf16x8*)(K_lds + (b) * SHM_K + kst0) = sk0[i]; *(bf16x8*)(K_lds + (b) * SHM_K + kst1) = sk1[i]; } \
    *(bf16x8*)(K_lds + (b) * SHM_K + kstt) = skt[i]; } while (0)
#define SWAIT() do { if (NQK == 12) asm volatile("s_waitcnt vmcnt(5)" ::: "memory"); else asm volatile("s_waitcnt vmcnt(3)" ::: "memory"); } while (0)
#define RESC(a) do { if (__any((a) < 1.f)) { if (hi == 0) al_l[r32] = (a); asm volatile("s_waitcnt lgkmcnt(0)" ::: "memory"); \
    _Pragma("unroll") for (int d = 0; d < 4; ++d) _Pragma("unroll") for (int r = 0; r < 16; ++r) o[d][r] *= al_l[crow(r, hi)]; } } while (0)
#define QKT(P0, P1, KS) do { if (PRE) qkt_pre<NQK>(P0, P1, KS, qr, r32, hi, m_reg); else qkt<NQK>(P0, P1, KS, qr, r32, hi); } while (0)
#define PSM(P0, P1, MN, AL, FIRST) do { if (PRE) partialSM_pre(P0, P1, m_reg, AL, FIRST); else partialSM<NQK>(P0, P1, m_reg, MN, AL); } while (0)
  f32x16 pA0, pA1, pB0, pB1; float mnA = 0.f, mnB = 0.f, alA, alB; bf16x8 pa0, pa1, pa2, pa3; const int NT = seq / 64;
  __syncthreads();
  SLOAD(0, 0); asm volatile("s_waitcnt vmcnt(0)" ::: "memory"); SWRITE(0, 0); __syncthreads();
  QKT(pA0, pA1, K_lds); PSM(pA0, pA1, mnA, alA, true);
  SLOAD(1, 64); if (2 < NT) SLOAD(0, 128);
  SWAIT(); SWRITE(1, 1); __syncthreads();
  for (int j = 1; j + 1 < NT; j += 2) {
    SBAR(); QKT(pB0, pB1, K_lds + SHM_K);
    finishSM(pA0, pA1, alA, l_reg, pa0, pa1, pa2, pa3); SBAR();
    SLOAD(1, (j + 2) * 64); SBAR();
    pv_d0(o, vb0, pa0, pa1, pa2, pa3); PSM(pB0, pB1, mnB, alB, false);
    __syncthreads(); SWAIT(); SWRITE(0, 0);
    RESC(alB); __syncthreads();
    SBAR(); QKT(pA0, pA1, K_lds);
    finishSM(pB0, pB1, alB, l_reg, pa0, pa1, pa2, pa3); SBAR();
    if (j + 3 < NT) SLOAD(0, (j + 3) * 64); SBAR();
    pv_d0(o, vb0 + SHM_V, pa0, pa1, pa2, pa3); PSM(pA0, pA1, mnA, alA, false);
    __syncthreads(); SWAIT(); SWRITE(1, 1);
    RESC(alA); __syncthreads();
  }
  SBAR(); QKT(pB0, pB1, K_lds + SHM_K);
  finishSM(pA0, pA1, alA, l_reg, pa0, pa1, pa2, pa3); SBAR();
  pv_d0(o, vb0, pa0, pa1, pa2, pa3); PSM(pB0, pB1, mnB, alB, false);
  __syncthreads(); RESC(alB);
  finishSM(pB0, pB1, alB, l_reg, pa0, pa1, pa2, pa3); SBAR();
  pv_d0(o, vb0 + SHM_V, pa0, pa1, pa2, pa3);
  if (hi == 0) li_l[r32] = l_reg; asm volatile("s_waitcnt lgkmcnt(0)" ::: "memory");
#pragma unroll
  for (int r = 0; r < 16; ++r) { const float rl = __builtin_amdgcn_rcpf(li_l[crow(r, hi)]);
#pragma unroll
    for (int d = 0; d < 4; ++d) o[d][r] *= rl; }
#undef SLOAD
#undef SWRITE
#undef SWAIT
#undef RESC
#undef QKT
#undef PSM
}

template <int NQK, bool PRE = false>
DEV void attn_body_s(const bf16_t* __restrict__ Qb, int ldq, const bf16_t* __restrict__ Kn, int ldkn, const bf16_t* __restrict__ Kt, int ldkt,
                     const bf16_t* __restrict__ Vh, int ldv, int seq, char* lds, f32x16 (&o)[4]) {
  typedef AttnK<NQK> CF;
  constexpr int SHM_V = CF::SHM_V, SHM_K = CF::SHM_K, KROWB = CF::KROWB, TAILC = CF::TAILC;
  const int tid = tidx(), wid = tid >> 6, lane = tid & 63, r32 = lane & 31, hi = lane >> 5;
  char* V_lds = lds; char* K_lds = lds + 2 * SHM_V;
  float* wsl = (float*)(lds + 2 * SHM_V + 2 * SHM_K) + wid * 64; float* li_l = wsl; float* al_l = wsl + 32;
  float m_reg = PRE ? 0.f : -1e30f, l_reg = 0;
#pragma unroll
  for (int d = 0; d < 4; ++d) o[d] = f32x16{};
  bf16x8 qr[NQK];
  const bf16_t* Qw = Qb + (size_t)(wid * 32 + r32) * ldq + hi * 8;
#pragma unroll
  for (int d0 = 0; d0 < NQK; ++d0) qr[d0] = *(const bf16x8*)(Qw + d0 * 16);
  const int sr = tid >> 4, sc = (tid & 15) * 8, vst0 = v_st(sr, sc), vst1 = v_st(32 + sr, sc);
  const int tr = tid >> 3, tc = (tid & 7) * 8;
  const int kst0 = sr * KROWB + ((sc * 2) ^ ((sr & 7) << 4)), kst1 = (32 + sr) * KROWB + ((sc * 2) ^ ((sr & 7) << 4));
  const int kstt = tr * KROWB + (((TAILC + tc) * 2) ^ ((tr & 7) << 4));
  const int vb0 = (int)(uintptr_t)V_lds + v_rd_base(lane);
  bf16x8 sv0, sv1, sk0, sk1, skt;
#define SLOAD1(k0) do { sv0 = *(const bf16x8*)(Vh + (size_t)((k0) + sr) * ldv + sc); sv1 = *(const bf16x8*)(Vh + (size_t)((k0) + 32 + sr) * ldv + sc); \
    if (NQK == 12) { sk0 = *(const bf16x8*)(Kn + (size_t)((k0) + sr) * ldkn + sc); sk1 = *(const bf16x8*)(Kn + (size_t)((k0) + 32 + sr) * ldkn + sc); } \
    skt = *(const bf16x8*)(Kt + (size_t)((k0) + tr) * ldkt + tc); } while (0)
#define SWRITE1(b) do { *(bf16x8*)(V_lds + (b) * SHM_V + vst0) = sv0; *(bf16x8*)(V_lds + (b) * SHM_V + vst1) = sv1; \
    if (NQK == 12) { *(bf16x8*)(K_lds + (b) * SHM_K + kst0) = sk0; *(bf16x8*)(K_lds + (b) * SHM_K + kst1) = sk1; } \
    *(bf16x8*)(K_lds + (b) * SHM_K + kstt) = skt; } while (0)
  f32x16 p0, p1; float mn, al; bf16x8 pa0, pa1, pa2, pa3; const int NT = seq / 64;
  __syncthreads();
  SLOAD1(0); SWRITE1(0); SLOAD1(64);
  __syncthreads();
  for (int j = 0; j < NT; ++j) {
    const int b = j & 1;
    if (j + 1 < NT) { SWRITE1(b ^ 1); if (j + 2 < NT) SLOAD1((j + 2) * 64); }
    if (PRE) { qkt_pre<NQK>(p0, p1, K_lds + b * SHM_K, qr, r32, hi, m_reg); partialSM_pre(p0, p1, m_reg, al, j == 0); }
    else { qkt<NQK>(p0, p1, K_lds + b * SHM_K, qr, r32, hi); partialSM<NQK>(p0, p1, m_reg, mn, al); }
    if (__any(al < 1.f)) { if (hi == 0) al_l[r32] = al; asm volatile("s_waitcnt lgkmcnt(0)" ::: "memory");
#pragma unroll
      for (int d = 0; d < 4; ++d)
#pragma unroll
        for (int r = 0; r < 16; ++r) o[d][r] *= al_l[crow(r, hi)]; }
    finishSM(p0, p1, al, l_reg, pa0, pa1, pa2, pa3);
    pv_d0(o, vb0 + b * SHM_V, pa0, pa1, pa2, pa3);
    __syncthreads();
  }
  if (hi == 0) li_l[r32] = l_reg; asm volatile("s_waitcnt lgkmcnt(0)" ::: "memory");
#pragma unroll
  for (int r = 0; r < 16; ++r) { const float rl = __builtin_amdgcn_rcpf(li_l[crow(r, hi)]);
#pragma unroll
    for (int d = 0; d < 4; ++d) o[d][r] *= rl; }
#undef SLOAD1
#undef SWRITE1
}

constexpr int H_RS = 272;
constexpr int H_TS = 144;
DEV void hgrn_prep(const bf16_t* __restrict__ z, const float* __restrict__ hg_lb, int tok0, int hh, int dir, int k, int qq, float* tot,
                   float (&cum)[16], float (&kk)[16], float& total, float& ref, const bf16_t (&fraw)[16]) {
  const int ch = hh * 128 + k;
  const float a0 = hg_lb[dir * 1024 + ch], a1 = hg_lb[dir * 1024 + 512 + ch];
  const float lb = 1.f / (1.f + __expf(a1 - a0));
#pragma unroll
  for (int i = 0; i < 16; ++i) { const float fp = bf2f(fraw[i]); const float sg = sigmoidf_(fp);
    cum[i] = __logf(lb + (1.f - lb) * sg); kk[i] = (1.f - lb) * (1.f - sg); }
  if (dir == 0) {
#pragma unroll
    for (int i = 1; i < 16; ++i) cum[i] += cum[i - 1];
    tot[qq * 128 + k] = cum[15];
  } else {
#pragma unroll
    for (int i = 14; i >= 0; --i) cum[i] += cum[i + 1];
    tot[qq * 128 + k] = cum[0];
  }
  __syncthreads();
  const float t0 = tot[k], t1 = tot[128 + k], t2 = tot[256 + k], t3 = tot[384 + k];
  total = (t0 + t1) + (t2 + t3);
  float offs;
  if (dir == 0) { offs = (qq > 0 ? t0 : 0.f) + (qq > 1 ? t1 : 0.f) + (qq > 2 ? t2 : 0.f); ref = t0 + t1; }
  else { offs = (qq < 3 ? t3 : 0.f) + (qq < 2 ? t2 : 0.f) + (qq < 1 ? t1 : 0.f); ref = t2 + t3; }
#pragma unroll
  for (int i = 0; i < 16; ++i) cum[i] += offs;
}
DEV void hgrn_load16(const bf16_t* __restrict__ p, bf16_t (&r)[16]) {
#pragma unroll
  for (int i = 0; i < 16; ++i) r[i] = p[(size_t)i * ZLD];
}
DEV void pack16_store(char* dst, const float (&v)[16]) {
  u32x4 w0, w1;
  w0.x = cvtpk(v[0], v[1]); w0.y = cvtpk(v[2], v[3]); w0.z = cvtpk(v[4], v[5]); w0.w = cvtpk(v[6], v[7]);
  w1.x = cvtpk(v[8], v[9]); w1.y = cvtpk(v[10], v[11]); w1.z = cvtpk(v[12], v[13]); w1.w = cvtpk(v[14], v[15]);
  *(u32x4*)dst = w0; *(u32x4*)(dst + 16) = w1;
}
DEV void hgrn_stepA(char* lds, const bf16_t* __restrict__ z, const float* __restrict__ hg_lb, bf16_t* __restrict__ ST, float* __restrict__ HD) {
  const int tid = tidx(), wid = tid >> 6, lane = tid & 63, fr = lane & 15, fq = lane >> 4, k = tid & 127, qq = tid >> 7;
  char* KdT = lds;
  char* VT = lds + 128 * H_TS;
  float* tot = (float*)(lds + 2 * 128 * H_TS);
  bf16_t pf[16], pv[16];
#define HA_LOAD(U) do { const int j_ = (U) & 127, r_ = (U) >> 7, d_ = r_ & 1, h_ = (r_ >> 1) & 3, b_ = r_ >> 3; \
    const bf16_t* zb_ = z + (size_t)(b_ * SEQ + j_ * 64 + qq * 16) * ZLD + h_ * 128 + k; hgrn_load16(zb_ + 512 + d_ * 512, pf); hgrn_load16(zb_ + 1536, pv); } while (0)
  { const int u0 = vblock(); if (u0 < 4096) HA_LOAD(u0); }
  for (int u = vblock(); u < 4096; u += gridDim.x) {
    const int j = u & 127, rest = u >> 7, dir = rest & 1, hh = (rest >> 1) & 3, b = rest >> 3;
    const int tok0 = b * SEQ + j * 64;
    float cum[16], kk[16], total, ref;
    bf16_t cf[16], cv[16];
#pragma unroll
    for (int i = 0; i < 16; ++i) { cf[i] = pf[i]; cv[i] = pv[i]; }
    if (u + (int)gridDim.x < 4096) HA_LOAD(u + (int)gridDim.x);
    __syncthreads();
    hgrn_prep(z, hg_lb, tok0, hh, dir, k, qq, tot, cum, kk, total, ref, cf);
    float kd[16], vv[16];
#pragma unroll
    for (int i = 0; i < 16; ++i) { kd[i] = kk[i] * __expf(total - cum[i]); vv[i] = bf2f(cv[i]); }
    pack16_store(KdT + k * H_TS + qq * 32, kd);
    pack16_store(VT + k * H_TS + qq * 32, vv);
    if (qq == 0) HD[(size_t)u * 128 + k] = __expf(total);
    __syncthreads();
    f32x4 acc[8];
#pragma unroll
    for (int m = 0; m < 8; ++m) acc[m] = (f32x4){0.f, 0.f, 0.f, 0.f};
#pragma unroll
    for (int ks = 0; ks < 2; ++ks) { const bf16x8 bv = *(const bf16x8*)(VT + (wid * 16 + fr) * H_TS + ks * 64 + fq * 16);
#pragma unroll
      for (int m = 0; m < 8; ++m) { const bf16x8 ak = *(const bf16x8*)(KdT + (m * 16 + fr) * H_TS + ks * 64 + fq * 16);
        acc[m] = __builtin_amdgcn_mfma_f32_16x16x32_bf16(ak, bv, acc[m], 0, 0, 0); } }
    bf16_t* sp = ST + (size_t)u * 16384 + (wid * 16 + fr) * 128 + 4 * fq;
#pragma unroll
    for (int m = 0; m < 8; ++m) { u32x2 w; w.x = cvtpk(acc[m][0], acc[m][1]); w.y = cvtpk(acc[m][2], acc[m][3]); *(u32x2*)(sp + m * 16) = w; }
  }
}
DEV void hgrn_stepB(bf16_t* __restrict__ ST, const float* __restrict__ HD) {
  for (int gid = blockIdx.x * NTHR + tidx(); gid < 32 * 4096; gid += gridDim.x * NTHR) {
    const int seq = gid >> 12, e = (gid & 4095) * 4, kq = e & 127, dir = seq & 1;
    float S0 = 0.f, S1 = 0.f, S2 = 0.f, S3 = 0.f;
    for (int s0 = 0; s0 < 128; s0 += 8) {
      u32x2 uu[8]; f32x4 dd[8];
#pragma unroll
      for (int i = 0; i < 8; ++i) { const int j = dir ? 127 - (s0 + i) : (s0 + i); const size_t un = (size_t)seq * 128 + j;
        uu[i] = *(const u32x2*)(ST + un * 16384 + e); dd[i] = *(const f32x4*)(HD + un * 128 + kq); }
#pragma unroll
      for (int i = 0; i < 8; ++i) { const int j = dir ? 127 - (s0 + i) : (s0 + i); const size_t un = (size_t)seq * 128 + j;
        u32x2 w; w.x = cvtpk(S0, S1); w.y = cvtpk(S2, S3); *(u32x2*)(ST + un * 16384 + e) = w;
        S0 = dd[i][0] * S0 + __uint_as_float(uu[i].x << 16); S1 = dd[i][1] * S1 + __uint_as_float(uu[i].x & 0xffff0000u);
        S2 = dd[i][2] * S2 + __uint_as_float(uu[i].y << 16); S3 = dd[i][3] * S3 + __uint_as_float(uu[i].y & 0xffff0000u); }
    }
  }
}
DEV void hgrn_stepC(char* lds, const bf16_t* __restrict__ z, const float* __restrict__ hg_lb, const float* __restrict__ hg_norm,
                    const bf16_t* __restrict__ ST, bf16_t* __restrict__ mix) {
  const int tid = tidx(), wid = tid >> 6, lane = tid & 63, fr = lane & 15, fq = lane >> 4, k = tid & 127, qq = tid >> 7;
  const int mt = wid & 3, chh = wid >> 2;
  char* Qd = lds; char* Kd = lds + 64 * H_RS; char* Qs = lds + 128 * H_RS;
  char* VT = lds + 192 * H_RS;
  char* Pm = VT + 128 * H_TS;
  float* tot = (float*)(Pm + 64 * H_TS);
  float* ssq = tot + 512;
  bf16_t pq[16], pv[16], pf0[16], pf1[16];
#define HC_LOAD(U) do { const int j_ = (U) & 127, h_ = ((U) >> 7) & 3, b_ = (U) >> 9; const bf16_t* zb_ = z + (size_t)(b_ * SEQ + j_ * 64 + qq * 16) * ZLD + h_ * 128 + k; \
    hgrn_load16(zb_, pq); hgrn_load16(zb_ + 512, pf0); hgrn_load16(zb_ + 1024, pf1); hgrn_load16(zb_ + 1536, pv); } while (0)
  { const int u0 = vblock(); if (u0 < 2048) HC_LOAD(u0); }
  for (int u = vblock(); u < 2048; u += gridDim.x) {
    const int j = u & 127, hh = (u >> 7) & 3, b = u >> 9;
    const int tok0 = b * SEQ + j * 64;
    bf16_t cq[16], cv[16], cf0[16], cf1[16];
#pragma unroll
    for (int i = 0; i < 16; ++i) { cq[i] = pq[i]; cv[i] = pv[i]; cf0[i] = pf0[i]; cf1[i] = pf1[i]; }
    if (u + (int)gridDim.x < 2048) HC_LOAD(u + (int)gridDim.x);
    f32x4 ao[4];
#pragma unroll
    for (int n = 0; n < 4; ++n) ao[n] = (f32x4){0.f, 0.f, 0.f, 0.f};
    for (int dir = 0; dir < 2; ++dir) {
      float cum[16], kk[16], total, ref;
      bf16_t cf[16];
#pragma unroll
      for (int i = 0; i < 16; ++i) cf[i] = dir ? cf1[i] : cf0[i];
      bf16x8 sfr[16];
      { const int un_ = ((b * 4 + hh) * 2 + dir) * 128 + j; const bf16_t* sp_ = ST + (size_t)un_ * 16384 + (size_t)(chh * 64 + fr) * 128 + fq * 8;
#pragma unroll
        for (int ks = 0; ks < 4; ++ks)
#pragma unroll
          for (int n = 0; n < 4; ++n) sfr[ks * 4 + n] = *(const bf16x8*)(sp_ + n * 16 * 128 + ks * 32); }
      __syncthreads();
      hgrn_prep(z, hg_lb, tok0, hh, dir, k, qq, tot, cum, kk, total, ref, cf);
#pragma unroll
      for (int i = 0; i < 16; ++i) { const int s = qq * 16 + i; const float qv = siluf_(bf2f(cq[i])) * 0.08838834764831845f;
        *(bf16_t*)(Qd + s * H_RS + k * 2) = f2bf(qv * __expf(cum[i] - ref));
        *(bf16_t*)(Kd + s * H_RS + k * 2) = f2bf(kk[i] * __expf(ref - cum[i]));
        *(bf16_t*)(Qs + s * H_RS + k * 2) = f2bf(qv * __expf(cum[i])); }
      if (dir == 0) { float vv[16];
#pragma unroll
        for (int i = 0; i < 16; ++i) vv[i] = bf2f(cv[i]);
        pack16_store(VT + k * H_TS + qq * 32, vv); }
      __syncthreads();
      f32x4 sc[2] = {(f32x4){0.f, 0.f, 0.f, 0.f}, (f32x4){0.f, 0.f, 0.f, 0.f}};
#pragma unroll
      for (int ks = 0; ks < 4; ++ks) { const bf16x8 qf = *(const bf16x8*)(Qd + (mt * 16 + fr) * H_RS + ks * 64 + fq * 16);
#pragma unroll
        for (int n = 0; n < 2; ++n) { const bf16x8 kf = *(const bf16x8*)(Kd + (chh * 32 + n * 16 + fr) * H_RS + ks * 64 + fq * 16);
          sc[n] = __builtin_amdgcn_mfma_f32_16x16x32_bf16(kf, qf, sc[n], 0, 0, 0); } }
      const int trow = mt * 16 + fr;
#pragma unroll
      for (int n = 0; n < 2; ++n) { float pv[4];
#pragma unroll
        for (int e = 0; e < 4; ++e) { const int s = chh * 32 + n * 16 + 4 * fq + e; const bool keep = dir == 0 ? (s <= trow) : (s >= trow); pv[e] = keep ? sc[n][e] : 0.f; }
        u32x2 w; w.x = cvtpk(pv[0], pv[1]); w.y = cvtpk(pv[2], pv[3]); *(u32x2*)(Pm + trow * H_TS + (chh * 32 + n * 16 + 4 * fq) * 2) = w; }
      const int un = ((b * 4 + hh) * 2 + dir) * 128 + j;
      const bf16_t* sp = ST + (size_t)un * 16384 + (size_t)(chh * 64 + fr) * 128 + fq * 8;
#pragma unroll
      for (int ks = 0; ks < 4; ++ks) { const bf16x8 qf = *(const bf16x8*)(Qs + (mt * 16 + fr) * H_RS + ks * 64 + fq * 16);
#pragma unroll
        for (int n = 0; n < 4; ++n) ao[n] = __builtin_amdgcn_mfma_f32_16x16x32_bf16(sfr[ks * 4 + n], qf, ao[n], 0, 0, 0); }
      __syncthreads();
#pragma unroll
      for (int ks = 0; ks < 2; ++ks) { const bf16x8 pf = *(const bf16x8*)(Pm + (mt * 16 + fr) * H_TS + ks * 64 + fq * 16);
#pragma unroll
        for (int n = 0; n < 4; ++n) { const bf16x8 vf = *(const bf16x8*)(VT + (chh * 64 + n * 16 + fr) * H_TS + ks * 64 + fq * 16);
          ao[n] = __builtin_amdgcn_mfma_f32_16x16x32_bf16(vf, pf, ao[n], 0, 0, 0); } }
    }
    float ss = 0.f;
#pragma unroll
    for (int n = 0; n < 4; ++n) ss += ao[n][0] * ao[n][0] + ao[n][1] * ao[n][1] + ao[n][2] * ao[n][2] + ao[n][3] * ao[n][3];
    ss += shfl_xor_f(ss, 16); ss += shfl_xor_f(ss, 32);
    if (fq == 0) ssq[chh * 64 + mt * 16 + fr] = ss;
    __syncthreads();
    const float rstd = rsqrtf((ssq[mt * 16 + fr] + ssq[64 + mt * 16 + fr]) * (1.f / 128.f) + EPS);
    const int tok = tok0 + mt * 16 + fr;
#pragma unroll
    for (int n = 0; n < 4; ++n) { const int v0 = chh * 64 + n * 16 + 4 * fq;
      const f32x4 gn = *(const f32x4*)(hg_norm + hh * 128 + v0);
      const u32x2 gz = *(const u32x2*)(z + (size_t)tok * ZLD + 2048 + hh * 128 + v0);
      const float g0 = siluf_(__uint_as_float(gz.x << 16)), g1 = siluf_(__uint_as_float(gz.x & 0xffff0000u)), g2 = siluf_(__uint_as_float(gz.y << 16)), g3 = siluf_(__uint_as_float(gz.y & 0xffff0000u));
      u32x2 w; w.x = cvtpk(ao[n][0] * rstd * gn[0] * g0, ao[n][1] * rstd * gn[1] * g1); w.y = cvtpk(ao[n][2] * rstd * gn[2] * g2, ao[n][3] * rstd * gn[3] * g3);
      *(u32x2*)(mix + (size_t)tok * DM + hh * 128 + v0) = w; }
  }
}

DEV void mla_phase(char* lds, const bf16_t* __restrict__ QF, const bf16_t* __restrict__ KVF, const bf16_t* __restrict__ Z, bf16_t* __restrict__ mix) {
  const int wid = tidx() >> 6, lane = tidx() & 63, r32 = lane & 31, hi = lane >> 5;
  for (int u = vblock(); u < 512; u += gridDim.x) {
    const int bh = u >> 5, qb = u & 31, b = bh >> 2, h = bh & 3;
    const size_t t0 = (size_t)b * SEQ;
    f32x16 o[4];
    attn_body_s<12, true>(QF + (t0 + qb * 256) * 768 + h * 192, 768, KVF + t0 * 1024 + h * 256, 1024, Z + t0 * ZLD + 3200, ZLD, KVF + t0 * 1024 + h * 256 + 128, 1024, SEQ, lds, o);
    bf16_t* op = mix + (t0 + qb * 256 + wid * 32) * DM + 512 + h * 128 + r32; asm volatile("" : "+v"(op));
#pragma unroll
    for (int r = 0; r < 16; ++r) { const int orow = crow(r, hi);
#pragma unroll
      for (int d0 = 0; d0 < 4; ++d0) op[(size_t)orow * DM + d0 * 32] = f2bf(o[d0][r]); }
  }
}
DEV void diff_phase(char* lds, const bf16_t* __restrict__ QKV, const Params& p, float* __restrict__ scr, bf16_t* __restrict__ mix) {
  const int wid = tidx() >> 6, lane = tidx() & 63, r32 = lane & 31, hi = lane >> 5;
  float d1 = p.lq1[lane] * p.lk1[lane], d2 = p.lq2[lane] * p.lk2[lane];
#pragma unroll
  for (int o = 32; o >= 1; o >>= 1) { d1 += shfl_xor_f(d1, o); d2 += shfl_xor_f(d2, o); }
  const float lam = __expf(d1) - __expf(d2) + LAMBDA_INIT;
  float* myscr = scr + (size_t)blockIdx.x * 32768 + wid * 4096 + lane;
  for (int u = vblock(); u < 1024; u += gridDim.x) {
    const int bh = u >> 5, qb = u & 31, b = bh >> 3, h = bh & 7;
    const size_t t0 = (size_t)b * SEQ;
    const bf16_t* base = QKV + t0 * 3072;
    f32x16 o[4];
#pragma unroll 1
    for (int c = 0; c < 2; ++c) {
      attn_body<4, true>(base + (size_t)(qb * 256) * 3072 + h * 128 + c * 64, 3072, nullptr, 0, base + 1024 + h * 128 + c * 64, 3072, base + 2048 + h * 128, 3072, SEQ, lds, o);
      if (c == 0) {
        float* wrscr = myscr; asm volatile("" : "+v"(wrscr));
#pragma unroll
        for (int d0 = 0; d0 < 4; ++d0)
#pragma unroll
          for (int r = 0; r < 16; ++r) wrscr[(d0 * 16 + r) * 64] = o[d0][r];
      }
    }
    float ss[16];
#pragma unroll
    for (int r = 0; r < 16; ++r) ss[r] = 0.f;
    const float* rdscr = myscr; asm volatile("" : "+v"(rdscr));
#pragma unroll
    for (int d0 = 0; d0 < 4; ++d0)
#pragma unroll
      for (int r = 0; r < 16; ++r) { const float v = rdscr[(d0 * 16 + r) * 64] - lam * o[d0][r]; o[d0][r] = v; ss[r] += v * v; }
#pragma unroll
    for (int r = 0; r < 16; ++r) {
#pragma unroll
      for (int s = 16; s >= 1; s >>= 1) ss[r] += shfl_xor_f(ss[r], s);
      ss[r] = rsqrtf(ss[r] * (1.f / 128.f) + EPS) * (1.f - LAMBDA_INIT); }
    bf16_t* op = mix + (t0 + qb * 256 + wid * 32) * DM + h * 128 + r32; asm volatile("" : "+v"(op));
#pragma unroll
    for (int d0 = 0; d0 < 4; ++d0) { const float gn = p.diff_norm[d0 * 32 + r32];
#pragma unroll
      for (int r = 0; r < 16; ++r) op[(size_t)crow(r, hi) * DM + d0 * 32] = f2bf(o[d0][r] * ss[r] * gn); }
  }
}


__global__ void __launch_bounds__(NTHR) fwd_megakernel(Params p) {
  extern __shared__ __attribute__((aligned(16))) char lds[];
  cg::grid_group grid = cg::this_grid();
  __shared__ __attribute__((aligned(16))) unsigned xb_words[4];
  if (threadIdx.x < 4) xb_words[threadIdx.x] = 0u;
  __syncthreads();
  (void)xcd_barrier_post((unsigned*)(p.ws + WS_BAR), (volatile LAS unsigned*)&xb_words[0]);
  unsigned char* ws = p.ws;
  bf16_t* W_in0 = (bf16_t*)(ws + WS_WIN0); bf16_t* W_uq = (bf16_t*)(ws + WS_WUQ); bf16_t* W_ukv = (bf16_t*)(ws + WS_WUKV); bf16_t* W_out0 = (bf16_t*)(ws + WS_WOUT0);
  bf16_t* W_gu = (bf16_t*)(ws + WS_WGU); bf16_t* W_dn = (bf16_t*)(ws + WS_WDN); bf16_t* W_cin = (bf16_t*)(ws + WS_WCIN); bf16_t* W_cout = (bf16_t*)(ws + WS_WCOUT);
  float* COS = (float*)(ws + WS_COS); float* SIN = (float*)(ws + WS_SIN); float* HD = (float*)(ws + WS_HD);
  bf16_t* HB = (bf16_t*)(ws + WS_HB); bf16_t* Z = (bf16_t*)(ws + WS_Z); bf16_t* CN = (bf16_t*)(ws + WS_CN); bf16_t* QF = (bf16_t*)(ws + WS_QF); bf16_t* KVF = (bf16_t*)(ws + WS_KVF);
  bf16_t* ST = (bf16_t*)p.out;
  float* SCR = (float*)(ws + WS_SCR);
  constexpr size_t WGU_E = (size_t)5632 * 1024, WDN_E = (size_t)1024 * 2816;

#define GSYNC() do { XcdBarrier xb_; xb_.bar = (unsigned*)(p.ws + WS_BAR); xb_.x = xb_xcc_id(); xb_.st = (volatile LAS unsigned*)&xb_words[0]; xcd_barrier(xb_); } while (0)
  {
    const int gtid = blockIdx.x * NTHR + tidx(), gsz = gridDim.x * NTHR;
    for (int i = gtid; i < SEQ * 32; i += gsz) { const int pos = i >> 5, jf = i & 31; const float ang = (float)pos * p.inv[jf];
      const double a = (double)ang; const double n = rint(a * 0.15915494309189535); const float r = (float)(a - n * 6.283185307179586);
      COS[i] = __cosf(r); SIN[i] = __sinf(r); }
    for (int i = gtid; i < 64 * 1024; i += gsz) W_in0[(size_t)3264 * 1024 + i] = 0;
    int xrot = 0;
    xpose_job(lds, p.ab_w_in, 1024, 3264, W_in0, 0, xrot);
    xpose_job(lds, p.w_uq, 384, 768, W_uq, 0, xrot);
    xpose_job(lds, p.w_ukv, 256, 1024, W_ukv, 0, xrot);
    xpose_job(lds, p.ab_w_out, 1024, 1024, W_out0, 0, xrot);
    for (int l = 0; l < 2; ++l) {
      xpose_job(lds, p.w_gate + (size_t)l * 1024 * FH, 1024, FH, W_gu + l * WGU_E, 1, xrot);
      xpose_job(lds, p.w_up + (size_t)l * 1024 * FH, 1024, FH, W_gu + l * WGU_E, 2, xrot);
      xpose_job(lds, p.w_down + (size_t)l * FH * 1024, FH, 1024, W_dn + l * WDN_E, 0, xrot);
    }
    xpose_job(lds, p.c_w_in, 1024, 3072, W_cin, 0, xrot);
    xpose_job(lds, p.c_w_out, 1024, 1024, W_cout, 0, xrot);
    rms_rows_bf16(p.x, p.norm_attn, HB);
  }
  asm volatile("s_waitcnt vmcnt(0)" ::: "memory"); grid.sync();
  { EpiStore e{Z, ZLD, 1, COS, SIN}; gemm_phase(lds, HB, 1024, W_in0, 1024, 1024, 13, 128 * 13, e); }
  GSYNC();
  cnorm_rows(Z, p.q_norm, p.kv_norm, CN);
  hgrn_stepA(lds, Z, p.hg_lb, ST, HD);
  GSYNC();
  hgrn_stepB(ST, HD);
  { EpiStore e{QF, 768, 2, COS, SIN}; gemm_phase<EpiStore, false>(lds, CN, 640, W_uq, 384, 384, 3, 128 * 3, e); }
  { EpiStore e{KVF, 1024, 0, COS, SIN}; gemm_phase<EpiStore, false>(lds, CN + 384, 640, W_ukv, 256, 256, 4, 128 * 4, e); }
  GSYNC();
  mla_phase(lds, QF, KVF, Z, HB);
  hgrn_stepC(lds, Z, p.hg_lb, p.hg_norm, ST, HB);
  GSYNC();
  { EpiResid e{p.x, p.out}; gemm_phase(lds, HB, 1024, W_out0, 1024, 1024, 4, 128 * 4, e); }
  GSYNC();
  for (int layer = 0; layer < 2; ++layer) {
    if (layer == 1) {
      rms_rows_bf16(p.out, p.norm_attn + 1024, HB);
      GSYNC();
      { EpiStore e{Z, 3072, 3, COS, SIN}; gemm_phase(lds, HB, 1024, W_cin, 1024, 1024, 12, 128 * 12, e); }
      GSYNC();
      diff_phase(lds, Z, p, SCR, HB);
      GSYNC();
      { EpiResid e{p.out, p.out}; gemm_phase(lds, HB, 1024, W_cout, 1024, 1024, 4, 128 * 4, e); }
      GSYNC();
    }
    rms_rows_bf16(p.out, p.norm_ffn + layer * 1024, HB);
    GSYNC();
    { EpiSwiglu e{Z}; gemm_phase(lds, HB, 1024, W_gu + layer * WGU_E, 1024, 1024, 22, 128 * 22, e); }
    GSYNC();
    { EpiResid e{p.out, p.out}; gemm_phase(lds, Z, FH, W_dn + layer * WDN_E, FH, FH, 4, 128 * 4, e); }
    GSYNC();
  }
  rms_rows_f32(p.out, p.final_norm);
}

extern "C" void kernel_launch(void* const* d_in, const int* in_sizes, int n_in, void* d_out, int out_size, void* d_ws, size_t ws_size, hipStream_t stream) {
  static int grid_blocks = 0;
  if (grid_blocks == 0) {
    if (n_in != 22 || out_size != T_TOK * DM || ws_size < WS_END) { fprintf(stderr, "kernel_launch: unexpected shapes n_in %d out %d ws %zu (need %zu)\n", n_in, out_size, ws_size, (size_t)WS_END); grid_blocks = -1; return; }
    int dev = 0, cus = 0, per_cu = 0;
    hipGetDevice(&dev);
    hipDeviceGetAttribute(&cus, hipDeviceAttributeMultiprocessorCount, dev);
    if (hipFuncSetAttribute((const void*)fwd_megakernel, hipFuncAttributeMaxDynamicSharedMemorySize, LDS_BYTES) != hipSuccess) { fprintf(stderr, "kernel_launch: hipFuncSetAttribute failed\n"); grid_blocks = -1; return; }
    if (hipOccupancyMaxActiveBlocksPerMultiprocessor(&per_cu, (const void*)fwd_megakernel, NTHR, LDS_BYTES) != hipSuccess || per_cu < 1) { fprintf(stderr, "kernel_launch: occupancy query gives %d\n", per_cu); per_cu = 1; }
    (void)hipGetLastError();
    grid_blocks = cus;
    if (grid_blocks % 8) grid_blocks -= grid_blocks % 8;
  }
  if (grid_blocks < 0) return;
  Params p{};
  const float** pf = (const float**)&p;
  for (int i = 0; i < 22; ++i) pf[i] = (const float*)d_in[i];
  p.out = (float*)d_out; p.ws = (unsigned char*)d_ws;
  for (int j = 0; j < 32; ++j) p.inv[j] = (float)(1.0 / pow(10000.0, (double)j / 32.0));
  if (hipMemsetAsync((char*)d_ws + WS_BAR, 0, XCD_BAR_WORDS * 4, stream) != hipSuccess) { fprintf(stderr, "kernel_launch: memset of the barrier words failed\n"); return; }
  void* args[] = {&p};
  hipError_t e = hipLaunchCooperativeKernel((const void*)fwd_megakernel, dim3(grid_blocks), dim3(NTHR), args, LDS_BYTES, stream);
  if (e != hipSuccess) fprintf(stderr, "kernel_launch: cooperative launch failed: %s (grid %d)\n", hipGetErrorString(e), grid_blocks);
}
```

```cpp
#include <hip/hip_runtime.h>
#include <hip/hip_cooperative_groups.h>
#include <cstdio>
#include <cstdint>
#include <cmath>
namespace cg = cooperative_groups;

typedef unsigned short bf16_t;
typedef short bf16x8 __attribute__((ext_vector_type(8)));
typedef short s16x4 __attribute__((ext_vector_type(4)));
typedef float f32x4 __attribute__((ext_vector_type(4)));
typedef float f32x16 __attribute__((ext_vector_type(16)));
typedef unsigned u32x4 __attribute__((ext_vector_type(4)));
typedef unsigned u32x2 __attribute__((ext_vector_type(2)));
#define DEV __device__ __forceinline__

constexpr int T_TOK = 32768, SEQ = 8192, NB = 4, DM = 1024, FH = 2816;
constexpr int ZLD = 3328;
constexpr int NTHR = 512;
constexpr float EPS = 1e-6f;
constexpr float LAMBDA_INIT = 0.35550906759096926f;

constexpr size_t al256(size_t x) { return (x + 255) / 256 * 256; }
constexpr size_t WS_WIN0 = 0;
constexpr size_t WS_WUQ = WS_WIN0 + al256((size_t)ZLD * 1024 * 2);
constexpr size_t WS_WUKV = WS_WUQ + al256((size_t)768 * 384 * 2);
constexpr size_t WS_WOUT0 = WS_WUKV + al256((size_t)1024 * 256 * 2);
constexpr size_t WS_WGU = WS_WOUT0 + al256((size_t)1024 * 1024 * 2);
constexpr size_t WS_WDN = WS_WGU + 2 * al256((size_t)5632 * 1024 * 2);
constexpr size_t WS_WCIN = WS_WDN + 2 * al256((size_t)1024 * 2816 * 2);
constexpr size_t WS_WCOUT = WS_WCIN + al256((size_t)3072 * 1024 * 2);
constexpr size_t WS_COS = WS_WCOUT + al256((size_t)1024 * 1024 * 2);
constexpr size_t WS_SIN = WS_COS + al256((size_t)8192 * 32 * 4);
constexpr size_t WS_HD = WS_SIN + al256((size_t)8192 * 32 * 4);
constexpr size_t WS_FLAG = WS_HD + al256((size_t)4096 * 128 * 4);
constexpr size_t WS_BAR = WS_FLAG + 4096;
constexpr size_t WS_HB = WS_BAR + 16384;
constexpr size_t WS_Z = WS_HB + al256((size_t)T_TOK * 1024 * 2);
constexpr size_t WS_CN = WS_Z + al256((size_t)T_TOK * ZLD * 2);
constexpr size_t WS_QF = WS_CN + al256((size_t)T_TOK * 640 * 2);
constexpr size_t WS_KVF = WS_QF + al256((size_t)T_TOK * 768 * 2);
constexpr size_t WS_END = WS_KVF + al256((size_t)T_TOK * 1024 * 2);
constexpr size_t WS_SCR = WS_CN;

constexpr int LDS_BYTES = 131072;

struct Params {
  const float* x; const float* norm_attn; const float* norm_ffn; const float* w_gate; const float* w_up; const float* w_down;
  const float* ab_w_in; const float* hg_lb; const float* hg_norm; const float* q_norm; const float* w_uq; const float* kv_norm;
  const float* w_ukv; const float* ab_w_out; const float* c_w_in; const float* lq1; const float* lk1; const float* lq2; const float* lk2;
  const float* diff_norm; const float* c_w_out; const float* final_norm;
  float* out; unsigned char* ws;
  float inv[32];
};

DEV float bf2f(bf16_t h) { return __uint_as_float(((unsigned)h) << 16); }
typedef float f32x2_t __attribute__((ext_vector_type(2))); typedef __bf16 bf16x2_t __attribute__((ext_vector_type(2)));
DEV unsigned cvtpk(float lo, float hi) { f32x2_t v = {lo, hi}; bf16x2_t b = __builtin_convertvector(v, bf16x2_t); return __builtin_bit_cast(unsigned, b); }
DEV bf16_t f2bf(float f) { return (bf16_t)(cvtpk(f, f) & 0xffffu); }
DEV float sigmoidf_(float x) { return __builtin_amdgcn_rcpf(1.f + __expf(-x)); }
DEV float siluf_(float x) { return x * __builtin_amdgcn_rcpf(1.f + __expf(-x)); }
DEV float shfl_xor_f(float v, int o) { int self = (int)__builtin_amdgcn_mbcnt_hi(~0u, __builtin_amdgcn_mbcnt_lo(~0u, 0u)); asm volatile("" : "+v"(self));
  return __int_as_float(__builtin_amdgcn_ds_bpermute((self ^ o) << 2, __float_as_int(v))); }
DEV int tidx() { int t = threadIdx.x; asm volatile("" : "+v"(t)); return t; }
DEV int vblock() { return (blockIdx.x & 7) * (gridDim.x >> 3) + (blockIdx.x >> 3); }

#define XB_TMO      128
#define XB_XCNT(j)  (256  + 64 * (j))
#define XB_XSUB(j)  (1280 + 64 * (j))
#define XB_XGEN(j)  (2304 + 64 * (j))
#define XB_TOP      3328
#define XB_TOPGEN   3392
#define XCD_BAR_WORDS 3456
#define XB_SPIN_CAP (1u << 18)
#define LAS __attribute__((address_space(3)))

__device__ __forceinline__ unsigned xb_ld(unsigned* p)              { return __hip_atomic_load(p, __ATOMIC_RELAXED, __HIP_MEMORY_SCOPE_AGENT); }
__device__ __forceinline__ unsigned xb_add(unsigned* p, unsigned v) { return __hip_atomic_fetch_add(p, v, __ATOMIC_RELAXED, __HIP_MEMORY_SCOPE_AGENT); }
__device__ __forceinline__ unsigned xb_xcc_id() { return (unsigned)__builtin_amdgcn_s_getreg((3 << 11) | 20) & 0xFu; }
#define XB_SPIN(cond, bar) do { unsigned _sp = 0; while (cond) { __builtin_amdgcn_s_sleep(1); \
    if ((++_sp & 255u) == 0u) { if (xb_ld(&(bar)[XB_TMO])) break; if (_sp > XB_SPIN_CAP) { atomicAdd(&(bar)[XB_TMO], 1u); break; } } } } while (0)

struct XcdBarrier {
    unsigned* bar; unsigned x;
    volatile LAS unsigned* st;
};

__device__ __forceinline__ XcdBarrier xcd_barrier_post(unsigned* bar, volatile LAS unsigned* st) {
    XcdBarrier b; b.bar = bar; b.x = xb_xcc_id(); b.st = st;
    if (threadIdx.x == 0) (void)xb_add(&bar[XB_XCNT(b.x)], 1u);
    return b;
}
__device__ __forceinline__ void xcd_barrier_complete(unsigned* bar, unsigned x, unsigned& nloc, unsigned& nx) {
    const unsigned G = gridDim.x * gridDim.y * gridDim.z;
    unsigned sum, cnt, mine, sp = 0u;
    for (;;) {
        sum = 0u; cnt = 0u; mine = 0u;
#pragma unroll
        for (unsigned j = 0; j < 16; ++j) { const unsigned c = xb_ld(&bar[XB_XCNT(j)]); sum += c; cnt += (c > 0u) ? 1u : 0u; mine = (j == x) ? c : mine; }
        if (sum == G) break;
        __builtin_amdgcn_s_sleep(1);
        if ((++sp & 255u) == 0u) { if (xb_ld(&bar[XB_TMO])) break; if (sp > XB_SPIN_CAP) { atomicAdd(&bar[XB_TMO], 1u); break; } }
    }
    nloc = mine > 0u ? mine : 1u; nx = cnt > 0u ? cnt : 1u;
}

__device__ __forceinline__ void xcd_barrier(const XcdBarrier& b) {
    asm volatile("s_waitcnt vmcnt(0)" ::: "memory");
    __syncthreads();
    if (threadIdx.x == 0) {
        unsigned* bar = b.bar;
        __builtin_amdgcn_s_waitcnt(0);
        unsigned nloc = b.st[0], nx = b.st[1];
        if (nloc == 0u) { xcd_barrier_complete(bar, b.x, nloc, nx); b.st[0] = nloc; b.st[1] = nx; }
        const unsigned old = xb_add(&bar[XB_XSUB(b.x)], 1u);
        const unsigned gen = old / nloc;
        if (old + 1u == (gen + 1u) * nloc) {
            __builtin_amdgcn_fence(__ATOMIC_RELEASE, "agent");
            asm volatile("s_waitcnt vmcnt(0)" ::: "memory");
            const unsigned og = xb_add(&bar[XB_TOP], 1u);
            const unsigned tg = og / nx;
            if (og + 1u == (tg + 1u) * nx) xb_add(&bar[XB_TOPGEN], 1u);
            else XB_SPIN(xb_ld(&bar[XB_TOPGEN]) == tg, bar);
            __builtin_amdgcn_fence(__ATOMIC_ACQUIRE, "agent");
            xb_add(&bar[XB_XGEN(b.x)], 1u);
            asm volatile("s_waitcnt vmcnt(0)" ::: "memory");
        } else {
            XB_SPIN(xb_ld(&bar[XB_XGEN(b.x)]) == gen, bar);
            __builtin_amdgcn_fence(__ATOMIC_ACQUIRE, "agent");
            asm volatile("s_waitcnt vmcnt(0)" ::: "memory");
        }
    }
    __syncthreads();
}


DEV void xpose_job(char* lds, const float* __restrict__ src, int K, int N, bf16_t* __restrict__ dst, int mode, int& rot) {
  float* tile = (float*)lds;
  const int nk = K >> 6, nn = (N + 255) >> 8, nt = nk * nn, tid = tidx();
  const int kr = tid >> 6, nl = tid & 63;
  int t0 = (int)blockIdx.x - rot; if (t0 < 0) t0 += gridDim.x;
  rot = (rot + nt) % (int)gridDim.x;
  for (int t = t0; t < nt; t += gridDim.x) {
    const int tk = t / nn, tn = t - tk * nn, k0 = tk * 64, n0 = tn * 256;
    float v[32];
#pragma unroll
    for (int c = 0; c < 4; ++c)
#pragma unroll
      for (int i = 0; i < 8; ++i) { const int gn = n0 + c * 64 + nl; v[c * 8 + i] = gn < N ? src[(size_t)(k0 + kr + 8 * i) * N + gn] : 0.f; }
    __syncthreads();
#pragma unroll
    for (int c = 0; c < 4; ++c)
#pragma unroll
      for (int i = 0; i < 8; ++i) tile[(kr + 8 * i) * 257 + c * 64 + nl] = v[c * 8 + i];
    __syncthreads();
#pragma unroll
    for (int j = 0; j < 16; ++j) {
      const int n = (tid >> 5) + 16 * j, kk = (tid & 31) * 2, gn = n0 + n;
      if (gn < N) { const int dn = mode == 0 ? gn : ((gn >> 4) * 32 + (gn & 15) + (mode == 2 ? 16 : 0));
        *(unsigned*)(dst + (size_t)dn * K + k0 + kk) = cvtpk(tile[kk * 257 + n], tile[(kk + 1) * 257 + n]); }
    }
  }
  __syncthreads();
}

DEV void rms_rows_bf16(const float* __restrict__ src, const float* __restrict__ gain, bf16_t* __restrict__ dst) {
  const int wid = tidx() >> 6, lane = tidx() & 63;
  f32x4 g[4];
#pragma unroll
  for (int i = 0; i < 4; ++i) g[i] = *(const f32x4*)(gain + lane * 4 + 256 * i);
  for (int row = blockIdx.x * 8 + wid; row < T_TOK; row += gridDim.x * 8) {
    const float* s = src + (size_t)row * DM; f32x4 v[4]; float ss = 0.f;
#pragma unroll
    for (int i = 0; i < 4; ++i) { v[i] = *(const f32x4*)(s + lane * 4 + 256 * i); ss += v[i][0] * v[i][0] + v[i][1] * v[i][1] + v[i][2] * v[i][2] + v[i][3] * v[i][3]; }
#pragma unroll
    for (int o = 32; o >= 1; o >>= 1) ss += shfl_xor_f(ss, o);
    const float r = rsqrtf(ss * (1.f / DM) + EPS);
#pragma unroll
    for (int i = 0; i < 4; ++i) { u32x2 w; w.x = cvtpk(v[i][0] * r * g[i][0], v[i][1] * r * g[i][1]); w.y = cvtpk(v[i][2] * r * g[i][2], v[i][3] * r * g[i][3]);
      *(u32x2*)(dst + (size_t)row * DM + lane * 4 + 256 * i) = w; }
  }
}
DEV void rms_rows_f32(float* __restrict__ buf, const float* __restrict__ gain) {
  const int wid = tidx() >> 6, lane = tidx() & 63;
  f32x4 g[4];
#pragma unroll
  for (int i = 0; i < 4; ++i) g[i] = *(const f32x4*)(gain + lane * 4 + 256 * i);
  for (int row = blockIdx.x * 8 + wid; row < T_TOK; row += gridDim.x * 8) {
    float* s = buf + (size_t)row * DM; f32x4 v[4]; float ss = 0.f;
#pragma unroll
    for (int i = 0; i < 4; ++i) { v[i] = *(const f32x4*)(s + lane * 4 + 256 * i); ss += v[i][0] * v[i][0] + v[i][1] * v[i][1] + v[i][2] * v[i][2] + v[i][3] * v[i][3]; }
#pragma unroll
    for (int o = 32; o >= 1; o >>= 1) ss += shfl_xor_f(ss, o);
    const float r = rsqrtf(ss * (1.f / DM) + EPS);
#pragma unroll
    for (int i = 0; i < 4; ++i) { f32x4 w = v[i] * r * g[i]; *(f32x4*)(s + lane * 4 + 256 * i) = w; }
  }
}
DEV void cnorm_rows(const bf16_t* __restrict__ z, const float* __restrict__ qg, const float* __restrict__ kg, bf16_t* __restrict__ cn) {
  const int wid = tidx() >> 6, lane = tidx() & 63;
  for (int row = blockIdx.x * 8 + wid; row < T_TOK; row += gridDim.x * 8) {
    const bf16_t* zr = z + (size_t)row * ZLD; float a[6], c[4]; float sa = 0.f, sc = 0.f;
#pragma unroll
    for (int i = 0; i < 6; ++i) { a[i] = bf2f(zr[2560 + lane + 64 * i]); sa += a[i] * a[i]; }
#pragma unroll
    for (int i = 0; i < 4; ++i) { c[i] = bf2f(zr[2944 + lane + 64 * i]); sc += c[i] * c[i]; }
#pragma unroll
    for (int o = 32; o >= 1; o >>= 1) { sa += shfl_xor_f(sa, o); sc += shfl_xor_f(sc, o); }
    const float ra = rsqrtf(sa * (1.f / 384.f) + EPS), rc = rsqrtf(sc * (1.f / 256.f) + EPS);
    bf16_t* o = cn + (size_t)row * 640;
#pragma unroll
    for (int i = 0; i < 6; ++i) o[lane + 64 * i] = f2bf(a[i] * ra * qg[lane + 64 * i]);
#pragma unroll
    for (int i = 0; i < 4; ++i) o[384 + lane + 64 * i] = f2bf(c[i] * rc * kg[lane + 64 * i]);
  }
}

constexpr int G_TILEB = 256 * 128, G_STAGEB = 2 * G_TILEB;

struct EpiStore {
  bf16_t* C; int ldc; int mode; const float* cs; const float* sn;
  DEV void operator()(f32x4 (&acc)[8][4], int row0, int col0, int fr, int fq) const {
    const int g = col0 >> 6; const bool rope = mode == 1 ? (g == 50) : mode == 2 ? (g % 3 == 2) : mode == 3 ? (g < 32) : false;
#pragma unroll
    for (int m = 0; m < 8; ++m) {
      const int row = row0 + m * 16 + fr;
      if (mode == 2) {
#pragma unroll
        for (int n = 0; n < 4; ++n) acc[m][n] = acc[m][n] * 0.10411754627697264f; }
      if (mode == 3 && col0 < 1024) {
#pragma unroll
        for (int n = 0; n < 4; ++n) acc[m][n] = acc[m][n] * 0.18033688011112042f; }
      if (rope) { const int pos = row & (SEQ - 1);
#pragma unroll
        for (int n = 0; n < 2; ++n) { const f32x4 c = *(const f32x4*)(cs + pos * 32 + n * 16 + 4 * fq), s = *(const f32x4*)(sn + pos * 32 + n * 16 + 4 * fq);
          const f32x4 x1 = acc[m][n], x2 = acc[m][n + 2]; acc[m][n] = x1 * c - x2 * s; acc[m][n + 2] = x2 * c + x1 * s; } }
#pragma unroll
      for (int n = 0; n < 4; ++n) { u32x2 w; w.x = cvtpk(acc[m][n][0], acc[m][n][1]); w.y = cvtpk(acc[m][n][2], acc[m][n][3]);
        *(u32x2*)(C + (size_t)row * ldc + col0 + n * 16 + 4 * fq) = w; }
    }
  }
};
struct EpiResid {
  const float* res; float* out;
  DEV void operator()(f32x4 (&acc)[8][4], int row0, int col0, int fr, int fq) const {
#pragma unroll
    for (int m = 0; m < 8; ++m) { const size_t ro = (size_t)(row0 + m * 16 + fr) * DM + col0 + 4 * fq;
#pragma unroll
      for (int n = 0; n < 4; ++n) { const f32x4 r = *(const f32x4*)(res + ro + n * 16); *(f32x4*)(out + ro + n * 16) = r + acc[m][n]; }
      if ((m & 3) == 3) asm volatile("" ::: "memory"); }
  }
};
struct EpiSwiglu {
  bf16_t* H;
  DEV void operator()(f32x4 (&acc)[8][4], int row0, int col0, int fr, int fq) const {
#pragma unroll
    for (int m = 0; m < 8; ++m) { bf16_t* hp = H + (size_t)(row0 + m * 16 + fr) * FH + (col0 >> 1) + 4 * fq;
#pragma unroll
      for (int i = 0; i < 2; ++i) { const f32x4 g = acc[m][2 * i], u = acc[m][2 * i + 1]; u32x2 w;
        w.x = cvtpk(siluf_(g[0]) * u[0], siluf_(g[1]) * u[1]); w.y = cvtpk(siluf_(g[2]) * u[2], siluf_(g[3]) * u[3]); *(u32x2*)(hp + i * 16) = w; } }
  }
};

template <class Epi, bool PF = true>
DEV void gemm_phase(char* lds, const bf16_t* __restrict__ A, int lda, const bf16_t* __restrict__ Bt, int ldb, int K, int nN, int nTiles, const Epi& E) {
  const int tid = tidx(), wid = tid >> 6, lane = tid & 63, wr = wid >> 2, wc = wid & 3, fr = lane & 15, fq = lane >> 4;
  const int nk = K >> 6, lrow = tid >> 3, lkc = tid & 7;
  const int hw = (((lrow >> 1) & 1) << 1) | (((lrow >> 3) & 1) << 2), hr = (((fr >> 1) & 1) << 1) | (((fr >> 3) & 1) << 2);
  const unsigned wofs = lrow * 128 + ((lkc ^ hw) << 4);
  const unsigned aofs0 = (wr * 128 + fr) * 128 + ((fq ^ hr) << 4), aofs1 = (wr * 128 + fr) * 128 + (((4 + fq) ^ hr) << 4);
  const unsigned bofs0 = G_TILEB + (wc * 64 + fr) * 128 + ((fq ^ hr) << 4), bofs1 = G_TILEB + (wc * 64 + fr) * 128 + (((4 + fq) ^ hr) << 4);
  const unsigned ao = (unsigned)(lrow * lda + lkc * 8) * 2u, bo = (unsigned)(lrow * ldb + lkc * 8) * 2u;
  const unsigned as64 = (unsigned)(64 * lda) * 2u, bs64 = (unsigned)(64 * ldb) * 2u;
  typedef __attribute__((address_space(3))) unsigned lds_u32;
  const unsigned gao = (unsigned)(lrow * lda + ((lkc ^ hw) << 3)) * 2u, gbo = (unsigned)(lrow * ldb + ((lkc ^ hw) << 3)) * 2u;
  const unsigned ldsw = (unsigned)wid * 1024u;
#define G_DMA(AB, BB, stg, k0) do { _Pragma("unroll") for (int i = 0; i < 4; ++i) { \
      __builtin_amdgcn_global_load_lds((const unsigned*)((AB) + (k0) * 2 + gao + i * as64), (lds_u32*)(lds + (stg) * G_STAGEB + ldsw + i * 8192), 16, 0, 0); \
      __builtin_amdgcn_global_load_lds((const unsigned*)((BB) + (k0) * 2 + gbo + i * bs64), (lds_u32*)(lds + (stg) * G_STAGEB + G_TILEB + ldsw + i * 8192), 16, 0, 0); } } while (0)
#define G_HALF(AO, BO, M0) do { _Pragma("unroll") for (int m = 0; m < 4; ++m) af[m] = *(const bf16x8*)(cur + (AO) + ((M0) + m) * 2048); \
      _Pragma("unroll") for (int m = 0; m < 4; ++m) _Pragma("unroll") for (int n = 0; n < 4; ++n) acc[(M0) + m][n] = __builtin_amdgcn_mfma_f32_16x16x32_bf16(bfr[n], af[m], acc[(M0) + m][n], 0, 0, 0); } while (0)
  int t = vblock();
  if (t >= nTiles) return;
  int pm = t / nN, pn = t - pm * nN;
  const char* Ab = (const char*)(A + (size_t)pm * 256 * lda);
  const char* Bb = (const char*)(Bt + (size_t)pn * 256 * ldb);
  __syncthreads();
  G_DMA(Ab, Bb, 0, 0);
  asm volatile("s_waitcnt vmcnt(0)" ::: "memory");
  __syncthreads();
  int stg = 0;
  for (;;) {
    f32x4 acc[8][4];
#pragma unroll
    for (int m = 0; m < 8; ++m)
#pragma unroll
      for (int n = 0; n < 4; ++n) acc[m][n] = (f32x4){0.f, 0.f, 0.f, 0.f};
    const int tn = t + (int)gridDim.x; const bool more = tn < nTiles;
    const int npm = more ? tn / nN : pm, npn = more ? tn - npm * nN : pn;
    const char* nAb = (const char*)(A + (size_t)npm * 256 * lda);
    const char* nBb = (const char*)(Bt + (size_t)npn * 256 * ldb);
    for (int kt = 0; kt < nk; ++kt) {
      const char* cur = lds + stg * G_STAGEB;
      if (kt + 1 < nk) G_DMA(Ab, Bb, stg ^ 1, (kt + 1) * 64);
      else if (more) G_DMA(nAb, nBb, stg ^ 1, 0);
      bf16x8 bfr[4], af[4];
#pragma unroll
      for (int n = 0; n < 4; ++n) bfr[n] = *(const bf16x8*)(cur + bofs0 + n * 2048);
#pragma unroll
      for (int m = 0; m < 4; ++m) af[m] = *(const bf16x8*)(cur + aofs0 + m * 2048);
#pragma unroll
      for (int m = 0; m < 4; ++m)
#pragma unroll
        for (int n = 0; n < 4; ++n) acc[m][n] = __builtin_amdgcn_mfma_f32_16x16x32_bf16(bfr[n], af[m], acc[m][n], 0, 0, 0);
      G_HALF(aofs0, bofs0, 4);
#pragma unroll
      for (int n = 0; n < 4; ++n) bfr[n] = *(const bf16x8*)(cur + bofs1 + n * 2048);
      G_HALF(aofs1, bofs1, 0);
      G_HALF(aofs1, bofs1, 4);
      asm volatile("s_waitcnt vmcnt(0)" ::: "memory");
      __syncthreads();
      stg ^= 1;
    }
    E(acc, pm * 256 + wr * 128, pn * 256 + wc * 64, fr, fq);
    if (!more) break;
    t = tn; pm = npm; pn = npn; Ab = nAb; Bb = nBb;
  }
#undef G_DMA
#undef G_HALF
}

#define SBAR() __builtin_amdgcn_sched_barrier(0)
DEV int crow(int r, int hi) { return (r & 3) + 8 * (r >> 2) + 4 * hi; }
constexpr float ATT_THR = 8.f;
template <int NQK> struct AttnK {
  static constexpr int DQK = NQK * 16, KROWB = DQK * 2, SHM_K = 64 * KROWB, SHM_V = 64 * 128 * 2, SHM = 2 * SHM_V + 2 * SHM_K + 8 * 64 * 4;
  static constexpr float SCALE = NQK == 12 ? 0.07216878364870323f : 0.125f;
  static constexpr int TAILC = NQK == 12 ? 128 : 0;
};
template <int NQK> DEV void partialSM(f32x16& p0, f32x16& p1, float& m_reg, float& mn, float& alpha) {
  constexpr float SC = AttnK<NQK>::SCALE, C = SC * 1.4426950408889634f;
  float pmax = p0[0];
#pragma unroll
  for (int r = 1; r < 16; ++r) pmax = fmaxf(pmax, p0[r]);
#pragma unroll
  for (int r = 0; r < 16; ++r) pmax = fmaxf(pmax, p1[r]);
  { auto rr = __builtin_amdgcn_permlane32_swap(__float_as_uint(pmax), __float_as_uint(pmax), false, false);
    pmax = fmaxf(__uint_as_float(rr[0]), __uint_as_float(rr[1])); }
  if (__builtin_expect(__all(pmax - m_reg <= ATT_THR / SC), 1)) { mn = m_reg; alpha = 1.f; }
  else { mn = fmaxf(m_reg, pmax); alpha = __builtin_amdgcn_exp2f((m_reg - mn) * C); m_reg = mn; }
  const float mnC = -mn * C;
#pragma unroll
  for (int r = 0; r < 16; ++r) p0[r] = fmaf(p0[r], C, mnC);
#pragma unroll
  for (int r = 0; r < 16; ++r) p1[r] = fmaf(p1[r], C, mnC);
#pragma unroll
  for (int r = 0; r < 16; ++r) p0[r] = __builtin_amdgcn_exp2f(p0[r]);
}
DEV void finishSM(f32x16& p0, f32x16& p1, float alpha, float& l_reg, bf16x8& pa0, bf16x8& pa1, bf16x8& pa2, bf16x8& pa3) {
#pragma unroll
  for (int r = 0; r < 16; ++r) p1[r] = __builtin_amdgcn_exp2f(p1[r]);
  float ps = 0;
#pragma unroll
  for (int r = 0; r < 16; ++r) ps += p0[r];
#pragma unroll
  for (int r = 0; r < 16; ++r) ps += p1[r];
  { auto rr = __builtin_amdgcn_permlane32_swap(__float_as_uint(ps), __float_as_uint(ps), false, false);
    ps = __uint_as_float(rr[0]) + __uint_as_float(rr[1]); }
  l_reg = l_reg * alpha + ps;
#define PK4(P, BASE, OUT) do { unsigned a0 = cvtpk(P[BASE + 0], P[BASE + 1]), a1 = cvtpk(P[BASE + 2], P[BASE + 3]);   \
    unsigned b0 = cvtpk(P[BASE + 4], P[BASE + 5]), b1 = cvtpk(P[BASE + 6], P[BASE + 7]);                              \
    auto r0 = __builtin_amdgcn_permlane32_swap(a0, b0, false, false); auto r1 = __builtin_amdgcn_permlane32_swap(a1, b1, false, false); \
    u32x4 w = {r0[0], r1[0], r0[1], r1[1]}; OUT = *reinterpret_cast<bf16x8*>(&w); } while (0)
  PK4(p0, 0, pa0); PK4(p0, 8, pa1); PK4(p1, 0, pa2); PK4(p1, 8, pa3);
#undef PK4
}
template <int NQK> DEV void qkt(f32x16& p0, f32x16& p1, const char* Ks, const bf16x8* qr, int r32, int hi) {
  constexpr int KROWB = AttnK<NQK>::KROWB;
  p0 = f32x16{}; p1 = f32x16{};
#pragma unroll
  for (int d0 = 0; d0 < NQK; ++d0) { const int cb = (d0 * 16 + hi * 8) * 2;
    const bf16x8 b0 = *reinterpret_cast<const bf16x8*>(Ks + r32 * KROWB + (cb ^ ((r32 & 7) << 4)));
    const bf16x8 b1 = *reinterpret_cast<const bf16x8*>(Ks + (32 + r32) * KROWB + (cb ^ ((r32 & 7) << 4)));
    p0 = __builtin_amdgcn_mfma_f32_32x32x16_bf16(b0, qr[d0], p0, 0, 0, 0);
    p1 = __builtin_amdgcn_mfma_f32_32x32x16_bf16(b1, qr[d0], p1, 0, 0, 0); }
}
DEV int v_st(int k, int c) { const int kk = (k & ~0xC) | ((k & 4) << 1) | ((k & 8) >> 1); return ((kk >> 3) * 4 + (c >> 5)) * 512 + ((kk & 7) * 32 + (c & 31)) * 2; }
DEV int v_rd_base(int lane) { return ((lane & 3) << 3) | (((lane >> 2) & 3) << 6) | (((lane >> 4) & 1) << 5) | (((lane >> 5) & 1) << 8); }
constexpr int v_rd_off(int d0, int ks, int half) { return d0 * 512 + ks * 4096 + half * 2048; }
template <int OFF> DEV s16x4 tr_read(int vb) { s16x4 r; asm volatile("ds_read_b64_tr_b16 %0, %1 offset:%2" : "=&v"(r) : "v"(vb), "i"(OFF) : "memory"); return r; }
template <int D0> DEV void pv_one(f32x16& od, int vb, bf16x8 pa0, bf16x8 pa1, bf16x8 pa2, bf16x8 pa3) {
  const s16x4 l0 = tr_read<v_rd_off(D0, 0, 0)>(vb), h0 = tr_read<v_rd_off(D0, 0, 1)>(vb), l1 = tr_read<v_rd_off(D0, 1, 0)>(vb), h1 = tr_read<v_rd_off(D0, 1, 1)>(vb);
  const s16x4 l2 = tr_read<v_rd_off(D0, 2, 0)>(vb), h2 = tr_read<v_rd_off(D0, 2, 1)>(vb), l3 = tr_read<v_rd_off(D0, 3, 0)>(vb), h3 = tr_read<v_rd_off(D0, 3, 1)>(vb);
  asm volatile("s_waitcnt lgkmcnt(0)" ::: "memory"); SBAR();
#define PKV(L, H) (bf16x8){L[0], L[1], L[2], L[3], H[0], H[1], H[2], H[3]}
  od = __builtin_amdgcn_mfma_f32_32x32x16_bf16(pa0, PKV(l0, h0), od, 0, 0, 0);
  od = __builtin_amdgcn_mfma_f32_32x32x16_bf16(pa1, PKV(l1, h1), od, 0, 0, 0);
  od = __builtin_amdgcn_mfma_f32_32x32x16_bf16(pa2, PKV(l2, h2), od, 0, 0, 0);
  od = __builtin_amdgcn_mfma_f32_32x32x16_bf16(pa3, PKV(l3, h3), od, 0, 0, 0);
#undef PKV
}
DEV void pv_d0(f32x16* o, int vb, bf16x8 pa0, bf16x8 pa1, bf16x8 pa2, bf16x8 pa3) {
  pv_one<0>(o[0], vb, pa0, pa1, pa2, pa3); pv_one<1>(o[1], vb, pa0, pa1, pa2, pa3); pv_one<2>(o[2], vb, pa0, pa1, pa2, pa3); pv_one<3>(o[3], vb, pa0, pa1, pa2, pa3);
}

template <int NQK> DEV void qkt_pre(f32x16& p0, f32x16& p1, const char* Ks, const bf16x8* qr, int r32, int hi, float m_reg) {
  constexpr int KROWB = AttnK<NQK>::KROWB;
  f32x16 nm;
#pragma unroll
  for (int r = 0; r < 16; ++r) nm[r] = -m_reg;
#pragma unroll
  for (int d0 = 0; d0 < NQK; ++d0) { const int cb = (d0 * 16 + hi * 8) * 2;
    const bf16x8 b0 = *reinterpret_cast<const bf16x8*>(Ks + r32 * KROWB + (cb ^ ((r32 & 7) << 4)));
    const bf16x8 b1 = *reinterpret_cast<const bf16x8*>(Ks + (32 + r32) * KROWB + (cb ^ ((r32 & 7) << 4)));
    p0 = __builtin_amdgcn_mfma_f32_32x32x16_bf16(b0, qr[d0], d0 == 0 ? nm : p0, 0, 0, 0);
    p1 = __builtin_amdgcn_mfma_f32_32x32x16_bf16(b1, qr[d0], d0 == 0 ? nm : p1, 0, 0, 0); }
}
DEV void partialSM_pre(f32x16& p0, f32x16& p1, float& m_reg, float& alpha, bool first) {
  constexpr float THRL = ATT_THR * 1.4426950408889634f;
  float pmax = p0[0];
#pragma unroll
  for (int r = 1; r < 16; ++r) pmax = fmaxf(pmax, p0[r]);
#pragma unroll
  for (int r = 0; r < 16; ++r) pmax = fmaxf(pmax, p1[r]);
  { auto rr = __builtin_amdgcn_permlane32_swap(__float_as_uint(pmax), __float_as_uint(pmax), false, false);
    pmax = fmaxf(__uint_as_float(rr[0]), __uint_as_float(rr[1])); }
  if (__builtin_expect(!first && __all(pmax <= THRL), 1)) { alpha = 1.f; }
  else { const float delta = first ? pmax : fmaxf(pmax, 0.f); alpha = first ? 1.f : __builtin_amdgcn_exp2f(-delta); m_reg += delta;
#pragma unroll
    for (int r = 0; r < 16; ++r) p0[r] -= delta;
#pragma unroll
    for (int r = 0; r < 16; ++r) p1[r] -= delta; }
#pragma unroll
  for (int r = 0; r < 16; ++r) p0[r] = __builtin_amdgcn_exp2f(p0[r]);
}
template <int NQK, bool PRE = false>
DEV void attn_body(const bf16_t* __restrict__ Qb, int ldq, const bf16_t* __restrict__ Kn, int ldkn, const bf16_t* __restrict__ Kt, int ldkt,
                   const bf16_t* __restrict__ Vh, int ldv, int seq, char* lds, f32x16 (&o)[4]) {
  typedef AttnK<NQK> CF;
  constexpr int SHM_V = CF::SHM_V, SHM_K = CF::SHM_K, KROWB = CF::KROWB, TAILC = CF::TAILC;
  const int tid = tidx(), wid = tid >> 6, lane = tid & 63, r32 = lane & 31, hi = lane >> 5;
  char* V_lds = lds; char* K_lds = lds + 2 * SHM_V;
  float* wsl = (float*)(lds + 2 * SHM_V + 2 * SHM_K) + wid * 64; float* li_l = wsl; float* al_l = wsl + 32;
  float m_reg = PRE ? 0.f : -1e30f, l_reg = 0;
#pragma unroll
  for (int d = 0; d < 4; ++d) o[d] = f32x16{};
  bf16x8 qr[NQK];
  const bf16_t* Qw = Qb + (size_t)(wid * 32 + r32) * ldq + hi * 8;
#pragma unroll
  for (int d0 = 0; d0 < NQK; ++d0) qr[d0] = *(const bf16x8*)(Qw + d0 * 16);
  const int sr = tid >> 4, sc = (tid & 15) * 8, vst0 = v_st(sr, sc), vst1 = v_st(32 + sr, sc);
  const int tr = tid >> 3, tc = (tid & 7) * 8;
  const int kst0 = sr * KROWB + ((sc * 2) ^ ((sr & 7) << 4)), kst1 = (32 + sr) * KROWB + ((sc * 2) ^ ((sr & 7) << 4));
  const int kstt = tr * KROWB + (((TAILC + tc) * 2) ^ ((tr & 7) << 4));
  const int vb0 = (int)(uintptr_t)V_lds + v_rd_base(lane);
  bf16x8 sv0[2], sv1[2], sk0[2], sk1[2], skt[2];
#define SLOAD(i, k0) do { sv0[i] = *(const bf16x8*)(Vh + (size_t)((k0) + sr) * ldv + sc); sv1[i] = *(const bf16x8*)(Vh + (size_t)((k0) + 32 + sr) * ldv + sc); \
    if (NQK == 12) { sk0[i] = *(const bf16x8*)(Kn + (size_t)((k0) + sr) * ldkn + sc); sk1[i] = *(const bf16x8*)(Kn + (size_t)((k0) + 32 + sr) * ldkn + sc); } \
    skt[i] = *(const bf16x8*)(Kt + (size_t)((k0) + tr) * ldkt + tc); } while (0)
#define SWRITE(b, i) do { *(bf16x8*)(V_lds + (b) * SHM_V + vst0) = sv0[i]; *(bf16x8*)(V_lds + (b) * SHM_V + vst1) = sv1[i]; \
    if (NQK == 12) { *(bf16x8*)(K_lds + (b) * SHM_K + kst0) = sk0[i]; *(bf16x8*)(K_lds + (b) * SHM_K + kst1) = sk1[i]; } \
    *(bf16x8*)(K_lds + (b) * SHM_K + kstt) = skt[i]; } while (0)
#define SWAIT() do { if (NQK == 12) asm volatile("s_waitcnt vmcnt(5)" ::: "memory"); else asm volatile("s_waitcnt vmcnt(3)" ::: "memory"); } while (0)
#define RESC(a) do { if (__any((a) < 1.f)) { if (hi == 0) al_l[r32] = (a); asm volatile("s_waitcnt lgkmcnt(0)" ::: "memory"); \
    _Pragma("unroll") for (int d = 0; d < 4; ++d) _Pragma("unroll") for (int r = 0; r < 16; ++r) o[d][r] *= al_l[crow(r, hi)]; } } while (0)
#define QKT(P0, P1, KS) do { if (PRE) qkt_pre<NQK>(P0, P1, KS, qr, r32, hi, m_reg); else qkt<NQK>(P0, P1, KS, qr, r32, hi); } while (0)
#define PSM(P0, P1, MN, AL, FIRST) do { if (PRE) partialSM_pre(P0, P1, m_reg, AL, FIRST); else partialSM<NQK>(P0, P1, m_reg, MN, AL); } while (0)
  f32x16 pA0, pA1, pB0, pB1; float mnA = 0.f, mnB = 0.f, alA, alB; bf16x8 pa0, pa1, pa2, pa3; const int NT = seq / 64;
  __syncthreads();
  SLOAD(0, 0); asm volatile("s_waitcnt vmcnt(0)" ::: "memory"); SWRITE(0, 0); __syncthreads();
  QKT(pA0, pA1, K_lds); PSM(pA0, pA1, mnA, alA, true);
  SLOAD(1, 64); if (2 < NT) SLOAD(0, 128);
  SWAIT(); SWRITE(1, 1); __syncthreads();
  for (int j = 1; j + 1 < NT; j += 2) {
    SBAR(); QKT(pB0, pB1, K_lds + SHM_K);
    finishSM(pA0, pA1, alA, l_reg, pa0, pa1, pa2, pa3); SBAR();
    SLOAD(1, (j + 2) * 64); SBAR();
    pv_d0(o, vb0, pa0, pa1, pa2, pa3); PSM(pB0, pB1, mnB, alB, false);
    __syncthreads(); SWAIT(); SWRITE(0, 0);
    RESC(alB); __syncthreads();
    SBAR(); QKT(pA0, pA1, K_lds);
    finishSM(pB0, pB1, alB, l_reg, pa0, pa1, pa2, pa3); SBAR();
    if (j + 3 < NT) SLOAD(0, (j + 3) * 64); SBAR();
    pv_d0(o, vb0 + SHM_V, pa0, pa1, pa2, pa3); PSM(pA0, pA1, mnA, alA, false);
    __syncthreads(); SWAIT(); SWRITE(1, 1);
    RESC(alA); __syncthreads();
  }
  SBAR(); QKT(pB0, pB1, K_lds + SHM_K);
  finishSM(pA0, pA1, alA, l_reg, pa0, pa1, pa2, pa3); SBAR();
  pv_d0(o, vb0, pa0, pa1, pa2, pa3); PSM(pB0, pB1, mnB, alB, false);
  __syncthreads(); RESC(alB);
  finishSM(pB0, pB1, alB, l_reg, pa0, pa1, pa2, pa3); SBAR();
  pv_d0(o, vb0 + SHM_V, pa0, pa1, pa2, pa3);
  if (hi == 0) li_l[r32] = l_reg; asm volatile("s_waitcnt lgkmcnt(0)" ::: "memory");
#pragma unroll
  for (int r = 0; r < 16; ++r) { const float rl = __builtin_amdgcn_rcpf(li_l[crow(r, hi)]);
#pragma unroll
    for (int d = 0; d < 4; ++d) o[d][r] *= rl; }
#undef SLOAD
#undef SWRITE
#undef SWAIT
#undef RESC
#undef QKT
#undef PSM
}

template <int NQK, bool PRE = false>
DEV void attn_body_s(const bf16_t* __restrict__ Qb, int ldq, const bf16_t* __restrict__ Kn, int ldkn, const bf16_t* __restrict__ Kt, int ldkt,
                     const bf16_t* __restrict__ Vh, int ldv, int seq, char* lds, f32x16 (&o)[4]) {
  typedef AttnK<NQK> CF;
  constexpr int SHM_V = CF::SHM_V, SHM_K = CF::SHM_K, KROWB = CF::KROWB, TAILC = CF::TAILC;
  const int tid = tidx(), wid = tid >> 6, lane = tid & 63, r32 = lane & 31, hi = lane >> 5;
  char* V_lds = lds; char* K_lds = lds + 2 * SHM_V;
  float* wsl = (float*)(lds + 2 * SHM_V + 2 * SHM_K) + wid * 64; float* li_l = wsl; float* al_l = wsl + 32;
  float m_reg = PRE ? 0.f : -1e30f, l_reg = 0;
#pragma unroll
  for (int d = 0; d < 4; ++d) o[d] = f32x16{};
  bf16x8 qr[NQK];
  const bf16_t* Qw = Qb + (size_t)(wid * 32 + r32) * ldq + hi * 8;
#pragma unroll
  for (int d0 = 0; d0 < NQK; ++d0) qr[d0] = *(const bf16x8*)(Qw + d0 * 16);
  const int sr = tid >> 4, sc = (tid & 15) * 8, vst0 = v_st(sr, sc), vst1 = v_st(32 + sr, sc);
  const int tr = tid >> 3, tc = (tid & 7) * 8;
  const int kst0 = sr * KROWB + ((sc * 2) ^ ((sr & 7) << 4)), kst1 = (32 + sr) * KROWB + ((sc * 2) ^ ((sr & 7) << 4));
  const int kstt = tr * KROWB + (((TAILC + tc) * 2) ^ ((tr & 7) << 4));
  const int vb0 = (int)(uintptr_t)V_lds + v_rd_base(lane);
  bf16x8 sv0, sv1, sk0, sk1, skt;
#define SLOAD1(k0) do { sv0 = *(const bf16x8*)(Vh + (size_t)((k0) + sr) * ldv + sc); sv1 = *(const bf16x8*)(Vh + (size_t)((k0) + 32 + sr) * ldv + sc); \
    if (NQK == 12) { sk0 = *(const bf16x8*)(Kn + (size_t)((k0) + sr) * ldkn + sc); sk1 = *(const bf16x8*)(Kn + (size_t)((k0) + 32 + sr) * ldkn + sc); } \
    skt = *(const bf16x8*)(Kt + (size_t)((k0) + tr) * ldkt + tc); } while (0)
#define SWRITE1(b) do { *(bf16x8*)(V_lds + (b) * SHM_V + vst0) = sv0; *(bf16x8*)(V_lds + (b) * SHM_V + vst1) = sv1; \
    if (NQK == 12) { *(bf16x8*)(K_lds + (b) * SHM_K + kst0) = sk0; *(bf16x8*)(K_lds + (b) * SHM_K + kst1) = sk1; } \
    *(bf16x8*)(K_lds + (b) * SHM_K + kstt) = skt; } while (0)
  f32x16 p0, p1; float mn, al; bf16x8 pa0, pa1, pa2, pa3; const int NT = seq / 64;
  __syncthreads();
  SLOAD1(0); SWRITE1(0); SLOAD1(64);
  __syncthreads();
  for (int j = 0; j < NT; ++j) {
    const int b = j & 1;
    if (j + 1 < NT) { SWRITE1(b ^ 1); if (j + 2 < NT) SLOAD1((j + 2) * 64); }
    if (PRE) { qkt_pre<NQK>(p0, p1, K_lds + b * SHM_K, qr, r32, hi, m_reg); partialSM_pre(p0, p1, m_reg, al, j == 0); }
    else { qkt<NQK>(p0, p1, K_lds + b * SHM_K, qr, r32, hi); partialSM<NQK>(p0, p1, m_reg, mn, al); }
    if (__any(al < 1.f)) { if (hi == 0) al_l[r32] = al; asm volatile("s_waitcnt lgkmcnt(0)" ::: "memory");
#pragma unroll
      for (int d = 0; d < 4; ++d)
#pragma unroll
        for (int r = 0; r < 16; ++r) o[d][r] *= al_l[crow(r, hi)]; }
    finishSM(p0, p1, al, l_reg, pa0, pa1, pa2, pa3);
    pv_d0(o, vb0 + b * SHM_V, pa0, pa1, pa2, pa3);
    __syncthreads();
  }
  if (hi == 0) li_l[r32] = l_reg; asm volatile("s_waitcnt lgkmcnt(0)" ::: "memory");
#pragma unroll
  for (int r = 0; r < 16; ++r) { const float rl = __builtin_amdgcn_rcpf(li_l[crow(r, hi)]);
#pragma unroll
    for (int d = 0; d < 4; ++d) o[d][r] *= rl; }
#undef SLOAD1
#undef SWRITE1
}

constexpr int H_RS = 272;
constexpr int H_TS = 144;
DEV void hgrn_prep(const bf16_t* __restrict__ z, const float* __restrict__ hg_lb, int tok0, int hh, int dir, int k, int qq, float* tot,
                   float (&cum)[16], float (&kk)[16], float& total, float& ref, const bf16_t (&fraw)[16]) {
  const int ch = hh * 128 + k;
  const float a0 = hg_lb[dir * 1024 + ch], a1 = hg_lb[dir * 1024 + 512 + ch];
  const float lb = 1.f / (1.f + __expf(a1 - a0));
#pragma unroll
  for (int i = 0; i < 16; ++i) { const float fp = bf2f(fraw[i]); const float sg = sigmoidf_(fp);
    cum[i] = __logf(lb + (1.f - lb) * sg); kk[i] = (1.f - lb) * (1.f - sg); }
  if (dir == 0) {
#pragma unroll
    for (int i = 1; i < 16; ++i) cum[i] += cum[i - 1];
    tot[qq * 128 + k] = cum[15];
  } else {
#pragma unroll
    for (int i = 14; i >= 0; --i) cum[i] += cum[i + 1];
    tot[qq * 128 + k] = cum[0];
  }
  __syncthreads();
  const float t0 = tot[k], t1 = tot[128 + k], t2 = tot[256 + k], t3 = tot[384 + k];
  total = (t0 + t1) + (t2 + t3);
  float offs;
  if (dir == 0) { offs = (qq > 0 ? t0 : 0.f) + (qq > 1 ? t1 : 0.f) + (qq > 2 ? t2 : 0.f); ref = t0 + t1; }
  else { offs = (qq < 3 ? t3 : 0.f) + (qq < 2 ? t2 : 0.f) + (qq < 1 ? t1 : 0.f); ref = t2 + t3; }
#pragma unroll
  for (int i = 0; i < 16; ++i) cum[i] += offs;
}
DEV void hgrn_load16(const bf16_t* __restrict__ p, bf16_t (&r)[16]) {
#pragma unroll
  for (int i = 0; i < 16; ++i) r[i] = p[(size_t)i * ZLD];
}
DEV void pack16_store(char* dst, const float (&v)[16]) {
  u32x4 w0, w1;
  w0.x = cvtpk(v[0], v[1]); w0.y = cvtpk(v[2], v[3]); w0.z = cvtpk(v[4], v[5]); w0.w = cvtpk(v[6], v[7]);
  w1.x = cvtpk(v[8], v[9]); w1.y = cvtpk(v[10], v[11]); w1.z = cvtpk(v[12], v[13]); w1.w = cvtpk(v[14], v[15]);
  *(u32x4*)dst = w0; *(u32x4*)(dst + 16) = w1;
}
DEV void hgrn_stepA(char* lds, const bf16_t* __restrict__ z, const float* __restrict__ hg_lb, bf16_t* __restrict__ ST, float* __restrict__ HD) {
  const int tid = tidx(), wid = tid >> 6, lane = tid & 63, fr = lane & 15, fq = lane >> 4, k = tid & 127, qq = tid >> 7;
  char* KdT = lds;
  char* VT = lds + 128 * H_TS;
  float* tot = (float*)(lds + 2 * 128 * H_TS);
  bf16_t pf[16], pv[16];
#define HA_LOAD(U) do { const int j_ = (U) & 127, r_ = (U) >> 7, d_ = r_ & 1, h_ = (r_ >> 1) & 3, b_ = r_ >> 3; \
    const bf16_t* zb_ = z + (size_t)(b_ * SEQ + j_ * 64 + qq * 16) * ZLD + h_ * 128 + k; hgrn_load16(zb_ + 512 + d_ * 512, pf); hgrn_load16(zb_ + 1536, pv); } while (0)
  { const int u0 = vblock(); if (u0 < 4096) HA_LOAD(u0); }
  for (int u = vblock(); u < 4096; u += gridDim.x) {
    const int j = u & 127, rest = u >> 7, dir = rest & 1, hh = (rest >> 1) & 3, b = rest >> 3;
    const int tok0 = b * SEQ + j * 64;
    float cum[16], kk[16], total, ref;
    bf16_t cf[16], cv[16];
#pragma unroll
    for (int i = 0; i < 16; ++i) { cf[i] = pf[i]; cv[i] = pv[i]; }
    if (u + (int)gridDim.x < 4096) HA_LOAD(u + (int)gridDim.x);
    __syncthreads();
    hgrn_prep(z, hg_lb, tok0, hh, dir, k, qq, tot, cum, kk, total, ref, cf);
    float kd[16], vv[16];
#pragma unroll
    for (int i = 0; i < 16; ++i) { kd[i] = kk[i] * __expf(total - cum[i]); vv[i] = bf2f(cv[i]); }
    pack16_store(KdT + k * H_TS + qq * 32, kd);
    pack16_store(VT + k * H_TS + qq * 32, vv);
    if (qq == 0) HD[(size_t)u * 128 + k] = __expf(total);
    __syncthreads();
    f32x4 acc[8];
#pragma unroll
    for (int m = 0; m < 8; ++m) acc[m] = (f32x4){0.f, 0.f, 0.f, 0.f};
#pragma unroll
    for (int ks = 0; ks < 2; ++ks) { const bf16x8 bv = *(const bf16x8*)(VT + (wid * 16 + fr) * H_TS + ks * 64 + fq * 16);
#pragma unroll
      for (int m = 0; m < 8; ++m) { const bf16x8 ak = *(const bf16x8*)(KdT + (m * 16 + fr) * H_TS + ks * 64 + fq * 16);
        acc[m] = __builtin_amdgcn_mfma_f32_16x16x32_bf16(ak, bv, acc[m], 0, 0, 0); } }
    bf16_t* sp = ST + (size_t)u * 16384 + (wid * 16 + fr) * 128 + 4 * fq;
#pragma unroll
    for (int m = 0; m < 8; ++m) { u32x2 w; w.x = cvtpk(acc[m][0], acc[m][1]); w.y = cvtpk(acc[m][2], acc[m][3]); *(u32x2*)(sp + m * 16) = w; }
  }
}
DEV void hgrn_stepB(bf16_t* __restrict__ ST, const float* __restrict__ HD) {
  for (int gid = blockIdx.x * NTHR + tidx(); gid < 32 * 4096; gid += gridDim.x * NTHR) {
    const int seq = gid >> 12, e = (gid & 4095) * 4, kq = e & 127, dir = seq & 1;
    float S0 = 0.f, S1 = 0.f, S2 = 0.f, S3 = 0.f;
    for (int s0 = 0; s0 < 128; s0 += 8) {
      u32x2 uu[8]; f32x4 dd[8];
#pragma unroll
      for (int i = 0; i < 8; ++i) { const int j = dir ? 127 - (s0 + i) : (s0 + i); const size_t un = (size_t)seq * 128 + j;
        uu[i] = *(const u32x2*)(ST + un * 16384 + e); dd[i] = *(const f32x4*)(HD + un * 128 + kq); }
#pragma unroll
      for (int i = 0; i < 8; ++i) { const int j = dir ? 127 - (s0 + i) : (s0 + i); const size_t un = (size_t)seq * 128 + j;
        u32x2 w; w.x = cvtpk(S0, S1); w.y = cvtpk(S2, S3); *(u32x2*)(ST + un * 16384 + e) = w;
        S0 = dd[i][0] * S0 + __uint_as_float(uu[i].x << 16); S1 = dd[i][1] * S1 + __uint_as_float(uu[i].x & 0xffff0000u);
        S2 = dd[i][2] * S2 + __uint_as_float(uu[i].y << 16); S3 = dd[i][3] * S3 + __uint_as_float(uu[i].y & 0xffff0000u); }
    }
  }
}
DEV void hgrn_stepC(char* lds, const bf16_t* __restrict__ z, const float* __restrict__ hg_lb, const float* __restrict__ hg_norm,
                    const bf16_t* __restrict__ ST, bf16_t* __restrict__ mix) {
  const int tid = tidx(), wid = tid >> 6, lane = tid & 63, fr = lane & 15, fq = lane >> 4, k = tid & 127, qq = tid >> 7;
  const int mt = wid & 3, chh = wid >> 2;
  char* Qd = lds; char* Kd = lds + 64 * H_RS; char* Qs = lds + 128 * H_RS;
  char* VT = lds + 192 * H_RS;
  char* Pm = VT + 128 * H_TS;
  float* tot = (float*)(Pm + 64 * H_TS);
  float* ssq = tot + 512;
  bf16_t pq[16], pv[16], pf0[16], pf1[16];
#define HC_LOAD(U) do { const int j_ = (U) & 127, h_ = ((U) >> 7) & 3, b_ = (U) >> 9; const bf16_t* zb_ = z + (size_t)(b_ * SEQ + j_ * 64 + qq * 16) * ZLD + h_ * 128 + k; \
    hgrn_load16(zb_, pq); hgrn_load16(zb_ + 512, pf0); hgrn_load16(zb_ + 1024, pf1); hgrn_load16(zb_ + 1536, pv); } while (0)
  { const int u0 = vblock(); if (u0 < 2048) HC_LOAD(u0); }
  for (int u = vblock(); u < 2048; u += gridDim.x) {
    const int j = u & 127, hh = (u >> 7) & 3, b = u >> 9;
    const int tok0 = b * SEQ + j * 64;
    bf16_t cq[16], cv[16], cf0[16], cf1[16];
#pragma unroll
    for (int i = 0; i < 16; ++i) { cq[i] = pq[i]; cv[i] = pv[i]; cf0[i] = pf0[i]; cf1[i] = pf1[i]; }
    if (u + (int)gridDim.x < 2048) HC_LOAD(u + (int)gridDim.x);
    f32x4 ao[4];
#pragma unroll
    for (int n = 0; n < 4; ++n) ao[n] = (f32x4){0.f, 0.f, 0.f, 0.f};
    for (int dir = 0; dir < 2; ++dir) {
      float cum[16], kk[16], total, ref;
      bf16_t cf[16];
#pragma unroll
      for (int i = 0; i < 16; ++i) cf[i] = dir ? cf1[i] : cf0[i];
      bf16x8 sfr[16];
      { const int un_ = ((b * 4 + hh) * 2 + dir) * 128 + j; const bf16_t* sp_ = ST + (size_t)un_ * 16384 + (size_t)(chh * 64 + fr) * 128 + fq * 8;
#pragma unroll
        for (int ks = 0; ks < 4; ++ks)
#pragma unroll
          for (int n = 0; n < 4; ++n) sfr[ks * 4 + n] = *(const bf16x8*)(sp_ + n * 16 * 128 + ks * 32); }
      __syncthreads();
      hgrn_prep(z, hg_lb, tok0, hh, dir, k, qq, tot, cum, kk, total, ref, cf);
#pragma unroll
      for (int i = 0; i < 16; ++i) { const int s = qq * 16 + i; const float qv = siluf_(bf2f(cq[i])) * 0.08838834764831845f;
        *(bf16_t*)(Qd + s * H_RS + k * 2) = f2bf(qv * __expf(cum[i] - ref));
        *(bf16_t*)(Kd + s * H_RS + k * 2) = f2bf(kk[i] * __expf(ref - cum[i]));
        *(bf16_t*)(Qs + s * H_RS + k * 2) = f2bf(qv * __expf(cum[i])); }
      if (dir == 0) { float vv[16];
#pragma unroll
        for (int i = 0; i < 16; ++i) vv[i] = bf2f(cv[i]);
        pack16_store(VT + k * H_TS + qq * 32, vv); }
      __syncthreads();
      f32x4 sc[2] = {(f32x4){0.f, 0.f, 0.f, 0.f}, (f32x4){0.f, 0.f, 0.f, 0.f}};
#pragma unroll
      for (int ks = 0; ks < 4; ++ks) { const bf16x8 qf = *(const bf16x8*)(Qd + (mt * 16 + fr) * H_RS + ks * 64 + fq * 16);
#pragma unroll
        for (int n = 0; n < 2; ++n) { const bf16x8 kf = *(const bf16x8*)(Kd + (chh * 32 + n * 16 + fr) * H_RS + ks * 64 + fq * 16);
          sc[n] = __builtin_amdgcn_mfma_f32_16x16x32_bf16(kf, qf, sc[n], 0, 0, 0); } }
      const int trow = mt * 16 + fr;
#pragma unroll
      for (int n = 0; n < 2; ++n) { float pv[4];
#pragma unroll
        for (int e = 0; e < 4; ++e) { const int s = chh * 32 + n * 16 + 4 * fq + e; const bool keep = dir == 0 ? (s <= trow) : (s >= trow); pv[e] = keep ? sc[n][e] : 0.f; }
        u32x2 w; w.x = cvtpk(pv[0], pv[1]); w.y = cvtpk(pv[2], pv[3]); *(u32x2*)(Pm + trow * H_TS + (chh * 32 + n * 16 + 4 * fq) * 2) = w; }
      const int un = ((b * 4 + hh) * 2 + dir) * 128 + j;
      const bf16_t* sp = ST + (size_t)un * 16384 + (size_t)(chh * 64 + fr) * 128 + fq * 8;
#pragma unroll
      for (int ks = 0; ks < 4; ++ks) { const bf16x8 qf = *(const bf16x8*)(Qs + (mt * 16 + fr) * H_RS + ks * 64 + fq * 16);
#pragma unroll
        for (int n = 0; n < 4; ++n) ao[n] = __builtin_amdgcn_mfma_f32_16x16x32_bf16(sfr[ks * 4 + n], qf, ao[n], 0, 0, 0); }
      __syncthreads();
#pragma unroll
      for (int ks = 0; ks < 2; ++ks) { const bf16x8 pf = *(const bf16x8*)(Pm + (mt * 16 + fr) * H_TS + ks * 64 + fq * 16);
#pragma unroll
        for (int n = 0; n < 4; ++n) { const bf16x8 vf = *(const bf16x8*)(VT + (chh * 64 + n * 16 + fr) * H_TS + ks * 64 + fq * 16);
          ao[n] = __builtin_amdgcn_mfma_f32_16x16x32_bf16(vf, pf, ao[n], 0, 0, 0); } }
    }
    float ss = 0.f;
#pragma unroll
    for (int n = 0; n < 4; ++n) ss += ao[n][0] * ao[n][0] + ao[n][1] * ao[n][1] + ao[n][2] * ao[n][2] + ao[n][3] * ao[n][3];
    ss += shfl_xor_f(ss, 16); ss += shfl_xor_f(ss, 32);
    if (fq == 0) ssq[chh * 64 + mt * 16 + fr] = ss;
    __syncthreads();
    const float rstd = rsqrtf((ssq[mt * 16 + fr] + ssq[64 + mt * 16 + fr]) * (1.f / 128.f) + EPS);
    const int tok = tok0 + mt * 16 + fr;
#pragma unroll
    for (int n = 0; n < 4; ++n) { const int v0 = chh * 64 + n * 16 + 4 * fq;
      const f32x4 gn = *(const f32x4*)(hg_norm + hh * 128 + v0);
      const u32x2 gz = *(const u32x2*)(z + (size_t)tok * ZLD + 2048 + hh * 128 + v0);
      const float g0 = siluf_(__uint_as_float(gz.x << 16)), g1 = siluf_(__uint_as_float(gz.x & 0xffff0000u)), g2 = siluf_(__uint_as_float(gz.y << 16)), g3 = siluf_(__uint_as_float(gz.y & 0xffff0000u));
      u32x2 w; w.x = cvtpk(ao[n][0] * rstd * gn[0] * g0, ao[n][1] * rstd * gn[1] * g1); w.y = cvtpk(ao[n][2] * rstd * gn[2] * g2, ao[n][3] * rstd * gn[3] * g3);
      *(u32x2*)(mix + (size_t)tok * DM + hh * 128 + v0) = w; }
  }
}

DEV void mla_phase(char* lds, const bf16_t* __restrict__ QF, const bf16_t* __restrict__ KVF, const bf16_t* __restrict__ Z, bf16_t* __restrict__ mix) {
  const int wid = tidx() >> 6, lane = tidx() & 63, r32 = lane & 31, hi = lane >> 5;
  for (int u = vblock(); u < 512; u += gridDim.x) {
    const int bh = u >> 5, qb = u & 31, b = bh >> 2, h = bh & 3;
    const size_t t0 = (size_t)b * SEQ;
    f32x16 o[4];
    attn_body_s<12, true>(QF + (t0 + qb * 256) * 768 + h * 192, 768, KVF + t0 * 1024 + h * 256, 1024, Z + t0 * ZLD + 3200, ZLD, KVF + t0 * 1024 + h * 256 + 128, 1024, SEQ, lds, o);
    bf16_t* op = mix + (t0 + qb * 256 + wid * 32) * DM + 512 + h * 128 + r32; asm volatile("" : "+v"(op));
#pragma unroll
    for (int r = 0; r < 16; ++r) { const int orow = crow(r, hi);
#pragma unroll
      for (int d0 = 0; d0 < 4; ++d0) op[(size_t)orow * DM + d0 * 32] = f2bf(o[d0][r]); }
  }
}
DEV void diff_phase(char* lds, const bf16_t* __restrict__ QKV, const Params& p, float* __restrict__ scr, bf16_t* __restrict__ mix) {
  const int wid = tidx() >> 6, lane = tidx() & 63, r32 = lane & 31, hi = lane >> 5;
  float d1 = p.lq1[lane] * p.lk1[lane], d2 = p.lq2[lane] * p.lk2[lane];
#pragma unroll
  for (int o = 32; o >= 1; o >>= 1) { d1 += shfl_xor_f(d1, o); d2 += shfl_xor_f(d2, o); }
  const float lam = __expf(d1) - __expf(d2) + LAMBDA_INIT;
  float* myscr = scr + (size_t)blockIdx.x * 32768 + wid * 4096 + lane;
  for (int u = vblock(); u < 1024; u += gridDim.x) {
    const int bh = u >> 5, qb = u & 31, b = bh >> 3, h = bh & 7;
    const size_t t0 = (size_t)b * SEQ;
    const bf16_t* base = QKV + t0 * 3072;
    f32x16 o[4];
#pragma unroll 1
    for (int c = 0; c < 2; ++c) {
      attn_body<4, true>(base + (size_t)(qb * 256) * 3072 + h * 128 + c * 64, 3072, nullptr, 0, base + 1024 + h * 128 + c * 64, 3072, base + 2048 + h * 128, 3072, SEQ, lds, o);
      if (c == 0) {
        float* wrscr = myscr; asm volatile("" : "+v"(wrscr));
#pragma unroll
        for (int d0 = 0; d0 < 4; ++d0)
#pragma unroll
          for (int r = 0; r < 16; ++r) wrscr[(d0 * 16 + r) * 64] = o[d0][r];
      }
    }
    float ss[16];
#pragma unroll
    for (int r = 0; r < 16; ++r) ss[r] = 0.f;
    const float* rdscr = myscr; asm volatile("" : "+v"(rdscr));
#pragma unroll
    for (int d0 = 0; d0 < 4; ++d0)
#pragma unroll
      for (int r = 0; r < 16; ++r) { const float v = rdscr[(d0 * 16 + r) * 64] - lam * o[d0][r]; o[d0][r] = v; ss[r] += v * v; }
#pragma unroll
    for (int r = 0; r < 16; ++r) {
#pragma unroll
      for (int s = 16; s >= 1; s >>= 1) ss[r] += shfl_xor_f(ss[r], s);
      ss[r] = rsqrtf(ss[r] * (1.f / 128.f) + EPS) * (1.f - LAMBDA_INIT); }
    bf16_t* op = mix + (t0 + qb * 256 + wid * 32) * DM + h * 128 + r32; asm volatile("" : "+v"(op));
#pragma unroll
    for (int d0 = 0; d0 < 4; ++d0) { const float gn = p.diff_norm[d0 * 32 + r32];
#pragma unroll
      for (int r = 0; r < 16; ++r) op[(size_t)crow(r, hi) * DM + d0 * 32] = f2bf(o[d0][r] * ss[r] * gn); }
  }
}


__global__ void __launch_bounds__(NTHR) fwd_megakernel(Params p) {
  extern __shared__ __attribute__((aligned(16))) char lds[];
  cg::grid_group grid = cg::this_grid();
  __shared__ __attribute__((aligned(16))) unsigned xb_words[4];
  if (threadIdx.x < 4) xb_words[threadIdx.x] = 0u;
  __syncthreads();
  (void)xcd_barrier_post((unsigned*)(p.ws + WS_BAR), (volatile LAS unsigned*)&xb_words[0]);
  unsigned char* ws = p.ws;
  bf16_t* W_in0 = (bf16_t*)(ws + WS_WIN0); bf16_t* W_uq = (bf16_t*)(ws + WS_WUQ); bf16_t* W_ukv = (bf16_t*)(ws + WS_WUKV); bf16_t* W_out0 = (bf16_t*)(ws + WS_WOUT0);
  bf16_t* W_gu = (bf16_t*)(ws + WS_WGU); bf16_t* W_dn = (bf16_t*)(ws + WS_WDN); bf16_t* W_cin = (bf16_t*)(ws + WS_WCIN); bf16_t* W_cout = (bf16_t*)(ws + WS_WCOUT);
  float* COS = (float*)(ws + WS_COS); float* SIN = (float*)(ws + WS_SIN); float* HD = (float*)(ws + WS_HD);
  bf16_t* HB = (bf16_t*)(ws + WS_HB); bf16_t* Z = (bf16_t*)(ws + WS_Z); bf16_t* CN = (bf16_t*)(ws + WS_CN); bf16_t* QF = (bf16_t*)(ws + WS_QF); bf16_t* KVF = (bf16_t*)(ws + WS_KVF);
  bf16_t* ST = (bf16_t*)p.out;
  float* SCR = (float*)(ws + WS_SCR);
  constexpr size_t WGU_E = (size_t)5632 * 1024, WDN_E = (size_t)1024 * 2816;

#define GSYNC() do { XcdBarrier xb_; xb_.bar = (unsigned*)(p.ws + WS_BAR); xb_.x = xb_xcc_id(); xb_.st = (volatile LAS unsigned*)&xb_words[0]; xcd_barrier(xb_); } while (0)
  {
    const int gtid = blockIdx.x * NTHR + tidx(), gsz = gridDim.x * NTHR;
    for (int i = gtid; i < SEQ * 32; i += gsz) { const int pos = i >> 5, jf = i & 31; const float ang = (float)pos * p.inv[jf];
      const double a = (double)ang; const double n = rint(a * 0.15915494309189535); const float r = (float)(a - n * 6.283185307179586);
      COS[i] = __cosf(r); SIN[i] = __sinf(r); }
    for (int i = gtid; i < 64 * 1024; i += gsz) W_in0[(size_t)3264 * 1024 + i] = 0;
    int xrot = 0;
    xpose_job(lds, p.ab_w_in, 1024, 3264, W_in0, 0, xrot);
    xpose_job(lds, p.w_uq, 384, 768, W_uq, 0, xrot);
    xpose_job(lds, p.w_ukv, 256, 1024, W_ukv, 0, xrot);
    xpose_job(lds, p.ab_w_out, 1024, 1024, W_out0, 0, xrot);
    for (int l = 0; l < 2; ++l) {
      xpose_job(lds, p.w_gate + (size_t)l * 1024 * FH, 1024, FH, W_gu + l * WGU_E, 1, xrot);
      xpose_job(lds, p.w_up + (size_t)l * 1024 * FH, 1024, FH, W_gu + l * WGU_E, 2, xrot);
      xpose_job(lds, p.w_down + (size_t)l * FH * 1024, FH, 1024, W_dn + l * WDN_E, 0, xrot);
    }
    xpose_job(lds, p.c_w_in, 1024, 3072, W_cin, 0, xrot);
    xpose_job(lds, p.c_w_out, 1024, 1024, W_cout, 0, xrot);
    rms_rows_bf16(p.x, p.norm_attn, HB);
  }
  asm volatile("s_waitcnt vmcnt(0)" ::: "memory"); grid.sync();
  { EpiStore e{Z, ZLD, 1, COS, SIN}; gemm_phase(lds, HB, 1024, W_in0, 1024, 1024, 13, 128 * 13, e); }
  GSYNC();
  cnorm_rows(Z, p.q_norm, p.kv_norm, CN);
  hgrn_stepA(lds, Z, p.hg_lb, ST, HD);
  GSYNC();
  hgrn_stepB(ST, HD);
  { EpiStore e{QF, 768, 2, COS, SIN}; gemm_phase<EpiStore, false>(lds, CN, 640, W_uq, 384, 384, 3, 128 * 3, e); }
  { EpiStore e{KVF, 1024, 0, COS, SIN}; gemm_phase<EpiStore, false>(lds, CN + 384, 640, W_ukv, 256, 256, 4, 128 * 4, e); }
  GSYNC();
  mla_phase(lds, QF, KVF, Z, HB);
  hgrn_stepC(lds, Z, p.hg_lb, p.hg_norm, ST, HB);
  GSYNC();
  { EpiResid e{p.x, p.out}; gemm_phase(lds, HB, 1024, W_out0, 1024, 1024, 4, 128 * 4, e); }
  GSYNC();
  for (int layer = 0; layer < 2; ++layer) {
    if (layer == 1) {
      rms_rows_bf16(p.out, p.norm_attn + 1024, HB);
      GSYNC();
      { EpiStore e{Z, 3072, 3, COS, SIN}; gemm_phase(lds, HB, 1024, W_cin, 1024, 1024, 12, 128 * 12, e); }
      GSYNC();
      diff_phase(lds, Z, p, SCR, HB);
      GSYNC();
      { EpiResid e{p.out, p.out}; gemm_phase(lds, HB, 1024, W_cout, 1024, 1024, 4, 128 * 4, e); }
      GSYNC();
    }
    rms_rows_bf16(p.out, p.norm_ffn + layer * 1024, HB);
    GSYNC();
    { EpiSwiglu e{Z}; gemm_phase(lds, HB, 1024, W_gu + layer * WGU_E, 1024, 1024, 22, 128 * 22, e); }
    GSYNC();
    { EpiResid e{p.out, p.out}; gemm_phase(lds, Z, FH, W_dn + layer * WDN_E, FH, FH, 4, 128 * 4, e); }
    GSYNC();
  }
  rms_rows_f32(p.out, p.final_norm);
}

extern "C" void kernel_launch(void* const* d_in, const int* in_sizes, int n_in, void* d_out, int out_size, void* d_ws, size_t ws_size, hipStream_t stream) {
  static int grid_blocks = 0;
  if (grid_blocks == 0) {
    if (n_in != 22 || out_size != T_TOK * DM || ws_size < WS_END) { fprintf(stderr, "kernel_launch: unexpected shapes n_in %d out %d ws %zu (need %zu)\n", n_in, out_size, ws_size, (size_t)WS_END); grid_blocks = -1; return; }
    int dev = 0, cus = 0, per_cu = 0;
    hipGetDevice(&dev);
    hipDeviceGetAttribute(&cus, hipDeviceAttributeMultiprocessorCount, dev);
    if (hipFuncSetAttribute((const void*)fwd_megakernel, hipFuncAttributeMaxDynamicSharedMemorySize, LDS_BYTES) != hipSuccess) { fprintf(stderr, "kernel_launch: hipFuncSetAttribute failed\n"); grid_blocks = -1; return; }
    if (hipOccupancyMaxActiveBlocksPerMultiprocessor(&per_cu, (const void*)fwd_megakernel, NTHR, LDS_BYTES) != hipSuccess || per_cu < 1) { fprintf(stderr, "kernel_launch: occupancy query gives %d\n", per_cu); per_cu = 1; }
    (void)hipGetLastError();
    grid_blocks = cus;
    if (grid_blocks % 8) grid_blocks -= grid_blocks % 8;
  }
  if (grid_blocks < 0) return;
  Params p{};
  const float** pf = (const float**)&p;
  for (int i = 0; i < 22; ++i) pf[i] = (const float*)d_in[i];
  p.out = (float*)d_out; p.ws = (unsigned char*)d_ws;
  for (int j = 0; j < 32; ++j) p.inv[j] = (float)(1.0 / pow(10000.0, (double)j / 32.0));
  if (hipMemsetAsync((char*)d_ws + WS_BAR, 0, XCD_BAR_WORDS * 4, stream) != hipSuccess) { fprintf(stderr, "kernel_launch: memset of the barrier words failed\n"); return; }
  void* args[] = {&p};
  hipError_t e = hipLaunchCooperativeKernel((const void*)fwd_megakernel, dim3(grid_blocks), dim3(NTHR), args, LDS_BYTES, stream);
  if (e != hipSuccess) fprintf(stderr, "kernel_launch: cooperative launch failed: %s (grid %d)\n", hipGetErrorString(e), grid_blocks);
}
```

```cpp
#include <hip/hip_runtime.h>
#include <hip/hip_cooperative_groups.h>
#include <cstdio>
#include <cstdint>
#include <cmath>
namespace cg = cooperative_groups;

typedef unsigned short bf16_t;
typedef short bf16x8 __attribute__((ext_vector_type(8)));
typedef short s16x4 __attribute__((ext_vector_type(4)));
typedef float f32x4 __attribute__((ext_vector_type(4)));
typedef float f32x16 __attribute__((ext_vector_type(16)));
typedef unsigned u32x4 __attribute__((ext_vector_type(4)));
typedef unsigned u32x2 __attribute__((ext_vector_type(2)));
#define DEV __device__ __forceinline__

constexpr int T_TOK = 32768, SEQ = 8192, NB = 4, DM = 1024, FH = 2816;
constexpr int ZLD = 3328;
constexpr int NTHR = 512;
constexpr float EPS = 1e-6f;
constexpr float LAMBDA_INIT = 0.35550906759096926f;

constexpr size_t al256(size_t x) { return (x + 255) / 256 * 256; }
constexpr size_t WS_WIN0 = 0;
constexpr size_t WS_WUQ = WS_WIN0 + al256((size_t)ZLD * 1024 * 2);
constexpr size_t WS_WUKV = WS_WUQ + al256((size_t)768 * 384 * 2);
constexpr size_t WS_WOUT0 = WS_WUKV + al256((size_t)1024 * 256 * 2);
constexpr size_t WS_WGU = WS_WOUT0 + al256((size_t)1024 * 1024 * 2);
constexpr size_t WS_WDN = WS_WGU + 2 * al256((size_t)5632 * 1024 * 2);
constexpr size_t WS_WCIN = WS_WDN + 2 * al256((size_t)1024 * 2816 * 2);
constexpr size_t WS_WCOUT = WS_WCIN + al256((size_t)3072 * 1024 * 2);
constexpr size_t WS_COS = WS_WCOUT + al256((size_t)1024 * 1024 * 2);
constexpr size_t WS_SIN = WS_COS + al256((size_t)8192 * 32 * 4);
constexpr size_t WS_HD = WS_SIN + al256((size_t)8192 * 32 * 4);
constexpr size_t WS_FLAG = WS_HD + al256((size_t)4096 * 128 * 4);
constexpr size_t WS_BAR = WS_FLAG + 4096;
constexpr size_t WS_HB = WS_BAR + 16384;
constexpr size_t WS_Z = WS_HB + al256((size_t)T_TOK * 1024 * 2);
constexpr size_t WS_CN = WS_Z + al256((size_t)T_TOK * ZLD * 2);
constexpr size_t WS_QF = WS_CN + al256((size_t)T_TOK * 640 * 2);
constexpr size_t WS_KVF = WS_QF + al256((size_t)T_TOK * 768 * 2);
constexpr size_t WS_END = WS_KVF + al256((size_t)T_TOK * 1024 * 2);
constexpr size_t WS_SCR = WS_CN;

constexpr int LDS_BYTES = 131072;

struct Params {
  const float* x; const float* norm_attn; const float* norm_ffn; const float* w_gate; const float* w_up; const float* w_down;
  const float* ab_w_in; const float* hg_lb; const float* hg_norm; const float* q_norm; const float* w_uq; const float* kv_norm;
  const float* w_ukv; const float* ab_w_out; const float* c_w_in; const float* lq1; const float* lk1; const float* lq2; const float* lk2;
  const float* diff_norm; const float* c_w_out; const float* final_norm;
  float* out; unsigned char* ws;
  float inv[32];
};

DEV float bf2f(bf16_t h) { return __uint_as_float(((unsigned)h) << 16); }
typedef float f32x2_t __attribute__((ext_vector_type(2))); typedef __bf16 bf16x2_t __attribute__((ext_vector_type(2)));
DEV unsigned cvtpk(float lo, float hi) { f32x2_t v = {lo, hi}; bf16x2_t b = __builtin_convertvector(v, bf16x2_t); return __builtin_bit_cast(unsigned, b); }
DEV bf16_t f2bf(float f) { return (bf16_t)(cvtpk(f, f) & 0xffffu); }
DEV float sigmoidf_(float x) { return __builtin_amdgcn_rcpf(1.f + __expf(-x)); }
DEV float siluf_(float x) { return x * __builtin_amdgcn_rcpf(1.f + __expf(-x)); }
DEV float shfl_xor_f(float v, int o) { int self = (int)__builtin_amdgcn_mbcnt_hi(~0u, __builtin_amdgcn_mbcnt_lo(~0u, 0u)); asm volatile("" : "+v"(self));
  return __int_as_float(__builtin_amdgcn_ds_bpermute((self ^ o) << 2, __float_as_int(v))); }
DEV int tidx() { int t = threadIdx.x; asm volatile("" : "+v"(t)); return t; }
DEV int vblock() { return (blockIdx.x & 7) * (gridDim.x >> 3) + (blockIdx.x >> 3); }

#define XB_TMO      128
#define XB_XCNT(j)  (256  + 64 * (j))
#define XB_XSUB(j)  (1280 + 64 * (j))
#define XB_XGEN(j)  (2304 + 64 * (j))
#define XB_TOP      3328
#define XB_TOPGEN   3392
#define XCD_BAR_WORDS 3456
#define XB_SPIN_CAP (1u << 18)
#define LAS __attribute__((address_space(3)))

__device__ __forceinline__ unsigned xb_ld(unsigned* p)              { return __hip_atomic_load(p, __ATOMIC_RELAXED, __HIP_MEMORY_SCOPE_AGENT); }
__device__ __forceinline__ unsigned xb_add(unsigned* p, unsigned v) { return __hip_atomic_fetch_add(p, v, __ATOMIC_RELAXED, __HIP_MEMORY_SCOPE_AGENT); }
__device__ __forceinline__ unsigned xb_xcc_id() { return (unsigned)__builtin_amdgcn_s_getreg((3 << 11) | 20) & 0xFu; }
#define XB_SPIN(cond, bar) do { unsigned _sp = 0; while (cond) { __builtin_amdgcn_s_sleep(1); \
    if ((++_sp & 255u) == 0u) { if (xb_ld(&(bar)[XB_TMO])) break; if (_sp > XB_SPIN_CAP) { atomicAdd(&(bar)[XB_TMO], 1u); break; } } } } while (0)

struct XcdBarrier {
    unsigned* bar; unsigned x;
    volatile LAS unsigned* st;
};

__device__ __forceinline__ XcdBarrier xcd_barrier_post(unsigned* bar, volatile LAS unsigned* st) {
    XcdBarrier b; b.bar = bar; b.x = xb_xcc_id(); b.st = st;
    if (threadIdx.x == 0) (void)xb_add(&bar[XB_XCNT(b.x)], 1u);
    return b;
}
__device__ __forceinline__ void xcd_barrier_complete(unsigned* bar, unsigned x, unsigned& nloc, unsigned& nx) {
    const unsigned G = gridDim.x * gridDim.y * gridDim.z;
    unsigned sum, cnt, mine, sp = 0u;
    for (;;) {
        sum = 0u; cnt = 0u; mine = 0u;
#pragma unroll
        for (unsigned j = 0; j < 16; ++j) { const unsigned c = xb_ld(&bar[XB_XCNT(j)]); sum += c; cnt += (c > 0u) ? 1u : 0u; mine = (j == x) ? c : mine; }
        if (sum == G) break;
        __builtin_amdgcn_s_sleep(1);
        if ((++sp & 255u) == 0u) { if (xb_ld(&bar[XB_TMO])) break; if (sp > XB_SPIN_CAP) { atomicAdd(&bar[XB_TMO], 1u); break; } }
    }
    nloc = mine > 0u ? mine : 1u; nx = cnt > 0u ? cnt : 1u;
}

__device__ __forceinline__ void xcd_barrier(const XcdBarrier& b) {
    asm volatile("s_waitcnt vmcnt(0)" ::: "memory");
    __syncthreads();
    if (threadIdx.x == 0) {
        unsigned* bar = b.bar;
        __builtin_amdgcn_s_waitcnt(0);
        unsigned nloc = b.st[0], nx = b.st[1];
        if (nloc == 0u) { xcd_barrier_complete(bar, b.x, nloc, nx); b.st[0] = nloc; b.st[1] = nx; }
        const unsigned old = xb_add(&bar[XB_XSUB(b.x)], 1u);
        const unsigned gen = old / nloc;
        if (old + 1u == (gen + 1u) * nloc) {
            __builtin_amdgcn_fence(__ATOMIC_RELEASE, "agent");
            asm volatile("s_waitcnt vmcnt(0)" ::: "memory");
            const unsigned og = xb_add(&bar[XB_TOP], 1u);
            const unsigned tg = og / nx;
            if (og + 1u == (tg + 1u) * nx) xb_add(&bar[XB_TOPGEN], 1u);
            else XB_SPIN(xb_ld(&bar[XB_TOPGEN]) == tg, bar);
            __builtin_amdgcn_fence(__ATOMIC_ACQUIRE, "agent");
            xb_add(&bar[XB_XGEN(b.x)], 1u);
            asm volatile("s_waitcnt vmcnt(0)" ::: "memory");
        } else {
            XB_SPIN(xb_ld(&bar[XB_XGEN(b.x)]) == gen, bar);
            __builtin_amdgcn_fence(__ATOMIC_ACQUIRE, "agent");
            asm volatile("s_waitcnt vmcnt(0)" ::: "memory");
        }
    }
    __syncthreads();
}


DEV void xpose_job(char* lds, const float* __restrict__ src, int K, int N, bf16_t* __restrict__ dst, int mode, int& rot) {
  float* tile = (float*)lds;
  const int nk = K >> 6, nn = (N + 255) >> 8, nt = nk * nn, tid = tidx();
  const int kr = tid >> 6, nl = tid & 63;
  int t0 = (int)blockIdx.x - rot; if (t0 < 0) t0 += gridDim.x;
  rot = (rot + nt) % (int)gridDim.x;
  for (int t = t0; t < nt; t += gridDim.x) {
    const int tk = t / nn, tn = t - tk * nn, k0 = tk * 64, n0 = tn * 256;
    float v[32];
#pragma unroll
    for (int c = 0; c < 4; ++c)
#pragma unroll
      for (int i = 0; i < 8; ++i) { const int gn = n0 + c * 64 + nl; v[c * 8 + i] = gn < N ? src[(size_t)(k0 + kr + 8 * i) * N + gn] : 0.f; }
    __syncthreads();
#pragma unroll
    for (int c = 0; c < 4; ++c)
#pragma unroll
      for (int i = 0; i < 8; ++i) tile[(kr + 8 * i) * 257 + c * 64 + nl] = v[c * 8 + i];
    __syncthreads();
#pragma unroll
    for (int j = 0; j < 16; ++j) {
      const int n = (tid >> 5) + 16 * j, kk = (tid & 31) * 2, gn = n0 + n;
      if (gn < N) { const int dn = mode == 0 ? gn : ((gn >> 4) * 32 + (gn & 15) + (mode == 2 ? 16 : 0));
        *(unsigned*)(dst + (size_t)dn * K + k0 + kk) = cvtpk(tile[kk * 257 + n], tile[(kk + 1) * 257 + n]); }
    }
  }
  __syncthreads();
}

DEV void rms_rows_bf16(const float* __restrict__ src, const float* __restrict__ gain, bf16_t* __restrict__ dst) {
  const int wid = tidx() >> 6, lane = tidx() & 63;
  f32x4 g[4];
#pragma unroll
  for (int i = 0; i < 4; ++i) g[i] = *(const f32x4*)(gain + lane * 4 + 256 * i);
  for (int row = blockIdx.x * 8 + wid; row < T_TOK; row += gridDim.x * 8) {
    const float* s = src + (size_t)row * DM; f32x4 v[4]; float ss = 0.f;
#pragma unroll
    for (int i = 0; i < 4; ++i) { v[i] = __builtin_nontemporal_load((const f32x4*)(s + lane * 4 + 256 * i)); ss += v[i][0] * v[i][0] + v[i][1] * v[i][1] + v[i][2] * v[i][2] + v[i][3] * v[i][3]; }
#pragma unroll
    for (int o = 32; o >= 1; o >>= 1) ss += shfl_xor_f(ss, o);
    const float r = rsqrtf(ss * (1.f / DM) + EPS);
#pragma unroll
    for (int i = 0; i < 4; ++i) { u32x2 w; w.x = cvtpk(v[i][0] * r * g[i][0], v[i][1] * r * g[i][1]); w.y = cvtpk(v[i][2] * r * g[i][2], v[i][3] * r * g[i][3]);
      *(u32x2*)(dst + (size_t)row * DM + lane * 4 + 256 * i) = w; }
  }
}
DEV void rms_rows_f32(float* __restrict__ buf, const float* __restrict__ gain) {
  const int wid = tidx() >> 6, lane = tidx() & 63;
  f32x4 g[4];
#pragma unroll
  for (int i = 0; i < 4; ++i) g[i] = *(const f32x4*)(gain + lane * 4 + 256 * i);
  for (int row = blockIdx.x * 8 + wid; row < T_TOK; row += gridDim.x * 8) {
    float* s = buf + (size_t)row * DM; f32x4 v[4]; float ss = 0.f;
#pragma unroll
    for (int i = 0; i < 4; ++i) { v[i] = *(const f32x4*)(s + lane * 4 + 256 * i); ss += v[i][0] * v[i][0] + v[i][1] * v[i][1] + v[i][2] * v[i][2] + v[i][3] * v[i][3]; }
#pragma unroll
    for (int o = 32; o >= 1; o >>= 1) ss += shfl_xor_f(ss, o);
    const float r = rsqrtf(ss * (1.f / DM) + EPS);
#pragma unroll
    for (int i = 0; i < 4; ++i) { f32x4 w = v[i] * r * g[i]; *(f32x4*)(s + lane * 4 + 256 * i) = w; }
  }
}
DEV void cnorm_rows(const bf16_t* __restrict__ z, const float* __restrict__ qg, const float* __restrict__ kg, bf16_t* __restrict__ cn) {
  const int wid = tidx() >> 6, lane = tidx() & 63;
  for (int row = blockIdx.x * 8 + wid; row < T_TOK; row += gridDim.x * 8) {
    const bf16_t* zr = z + (size_t)row * ZLD; float a[6], c[4]; float sa = 0.f, sc = 0.f;
#pragma unroll
    for (int i = 0; i < 6; ++i) { a[i] = bf2f(zr[2560 + lane + 64 * i]); sa += a[i] * a[i]; }
#pragma unroll
    for (int i = 0; i < 4; ++i) { c[i] = bf2f(zr[2944 + lane + 64 * i]); sc += c[i] * c[i]; }
#pragma unroll
    for (int o = 32; o >= 1; o >>= 1) { sa += shfl_xor_f(sa, o); sc += shfl_xor_f(sc, o); }
    const float ra = rsqrtf(sa * (1.f / 384.f) + EPS), rc = rsqrtf(sc * (1.f / 256.f) + EPS);
    bf16_t* o = cn + (size_t)row * 640;
#pragma unroll
    for (int i = 0; i < 6; ++i) o[lane + 64 * i] = f2bf(a[i] * ra * qg[lane + 64 * i]);
#pragma unroll
    for (int i = 0; i < 4; ++i) o[384 + lane + 64 * i] = f2bf(c[i] * rc * kg[lane + 64 * i]);
  }
}

constexpr int G_TILEB = 256 * 128, G_STAGEB = 2 * G_TILEB;

struct EpiStore {
  bf16_t* C; int ldc; int mode; const float* cs; const float* sn;
  DEV void operator()(f32x4 (&acc)[8][4], int row0, int col0, int fr, int fq) const {
    const int g = col0 >> 6; const bool rope = mode == 1 ? (g == 50) : mode == 2 ? (g % 3 == 2) : mode == 3 ? (g < 32) : false;
#pragma unroll
    for (int m = 0; m < 8; ++m) {
      const int row = row0 + m * 16 + fr;
      if (mode == 2) {
#pragma unroll
        for (int n = 0; n < 4; ++n) acc[m][n] = acc[m][n] * 0.10411754627697264f; }
      if (mode == 3 && col0 < 1024) {
#pragma unroll
        for (int n = 0; n < 4; ++n) acc[m][n] = acc[m][n] * 0.18033688011112042f; }
      if (rope) { const int pos = row & (SEQ - 1);
#pragma unroll
        for (int n = 0; n < 2; ++n) { const f32x4 c = *(const f32x4*)(cs + pos * 32 + n * 16 + 4 * fq), s = *(const f32x4*)(sn + pos * 32 + n * 16 + 4 * fq);
          const f32x4 x1 = acc[m][n], x2 = acc[m][n + 2]; acc[m][n] = x1 * c - x2 * s; acc[m][n + 2] = x2 * c + x1 * s; } }
#pragma unroll
      for (int n = 0; n < 4; ++n) { u32x2 w; w.x = cvtpk(acc[m][n][0], acc[m][n][1]); w.y = cvtpk(acc[m][n][2], acc[m][n][3]);
        *(u32x2*)(C + (size_t)row * ldc + col0 + n * 16 + 4 * fq) = w; }
    }
  }
};
struct EpiResid {
  const float* res; float* out;
  DEV void operator()(f32x4 (&acc)[8][4], int row0, int col0, int fr, int fq) const {
#pragma unroll
    for (int m = 0; m < 8; ++m) { const size_t ro = (size_t)(row0 + m * 16 + fr) * DM + col0 + 4 * fq;
#pragma unroll
      for (int n = 0; n < 4; ++n) { const f32x4 r = *(const f32x4*)(res + ro + n * 16); *(f32x4*)(out + ro + n * 16) = r + acc[m][n]; }
      if ((m & 3) == 3) asm volatile("" ::: "memory"); }
  }
};
struct EpiSwiglu {
  bf16_t* H;
  DEV void operator()(f32x4 (&acc)[8][4], int row0, int col0, int fr, int fq) const {
#pragma unroll
    for (int m = 0; m < 8; ++m) { bf16_t* hp = H + (size_t)(row0 + m * 16 + fr) * FH + (col0 >> 1) + 4 * fq;
#pragma unroll
      for (int i = 0; i < 2; ++i) { const f32x4 g = acc[m][2 * i], u = acc[m][2 * i + 1]; u32x2 w;
        w.x = cvtpk(siluf_(g[0]) * u[0], siluf_(g[1]) * u[1]); w.y = cvtpk(siluf_(g[2]) * u[2], siluf_(g[3]) * u[3]); *(u32x2*)(hp + i * 16) = w; } }
  }
};

template <class Epi, bool PF = true>
DEV void gemm_phase(char* lds, const bf16_t* __restrict__ A, int lda, const bf16_t* __restrict__ Bt, int ldb, int K, int nN, int nTiles, const Epi& E) {
  const int tid = tidx(), wid = tid >> 6, lane = tid & 63, wr = wid >> 2, wc = wid & 3, fr = lane & 15, fq = lane >> 4;
  const int nk = K >> 6, lrow = tid >> 3, lkc = tid & 7;
  const int hw = (((lrow >> 1) & 1) << 1) | (((lrow >> 3) & 1) << 2), hr = (((fr >> 1) & 1) << 1) | (((fr >> 3) & 1) << 2);
  const unsigned wofs = lrow * 128 + ((lkc ^ hw) << 4);
  const unsigned aofs0 = (wr * 128 + fr) * 128 + ((fq ^ hr) << 4), aofs1 = (wr * 128 + fr) * 128 + (((4 + fq) ^ hr) << 4);
  const unsigned bofs0 = G_TILEB + (wc * 64 + fr) * 128 + ((fq ^ hr) << 4), bofs1 = G_TILEB + (wc * 64 + fr) * 128 + (((4 + fq) ^ hr) << 4);
  const unsigned ao = (unsigned)(lrow * lda + lkc * 8) * 2u, bo = (unsigned)(lrow * ldb + lkc * 8) * 2u;
  const unsigned as64 = (unsigned)(64 * lda) * 2u, bs64 = (unsigned)(64 * ldb) * 2u;
  typedef __attribute__((address_space(3))) unsigned lds_u32;
  const unsigned gao = (unsigned)(lrow * lda + ((lkc ^ hw) << 3)) * 2u, gbo = (unsigned)(lrow * ldb + ((lkc ^ hw) << 3)) * 2u;
  const unsigned ldsw = (unsigned)wid * 1024u;
#define G_DMA(AB, BB, stg, k0) do { _Pragma("unroll") for (int i = 0; i < 4; ++i) { \
      __builtin_amdgcn_global_load_lds((const unsigned*)((AB) + (k0) * 2 + gao + i * as64), (lds_u32*)(lds + (stg) * G_STAGEB + ldsw + i * 8192), 16, 0, 0); \
      __builtin_amdgcn_global_load_lds((const unsigned*)((BB) + (k0) * 2 + gbo + i * bs64), (lds_u32*)(lds + (stg) * G_STAGEB + G_TILEB + ldsw + i * 8192), 16, 0, 0); } } while (0)
#define G_HALF(AO, BO, M0) do { _Pragma("unroll") for (int m = 0; m < 4; ++m) af[m] = *(const bf16x8*)(cur + (AO) + ((M0) + m) * 2048); \
      _Pragma("unroll") for (int m = 0; m < 4; ++m) _Pragma("unroll") for (int n = 0; n < 4; ++n) acc[(M0) + m][n] = __builtin_amdgcn_mfma_f32_16x16x32_bf16(bfr[n], af[m], acc[(M0) + m][n], 0, 0, 0); } while (0)
  int t = vblock();
  if (t >= nTiles) return;
  int pm = t / nN, pn = t - pm * nN;
  const char* Ab = (const char*)(A + (size_t)pm * 256 * lda);
  const char* Bb = (const char*)(Bt + (size_t)pn * 256 * ldb);
  __syncthreads();
  G_DMA(Ab, Bb, 0, 0);
  asm volatile("s_waitcnt vmcnt(0)" ::: "memory");
  __syncthreads();
  int stg = 0;
  for (;;) {
    f32x4 acc[8][4];
#pragma unroll
    for (int m = 0; m < 8; ++m)
#pragma unroll
      for (int n = 0; n < 4; ++n) acc[m][n] = (f32x4){0.f, 0.f, 0.f, 0.f};
    const int tn = t + (int)gridDim.x; const bool more = tn < nTiles;
    const int npm = more ? tn / nN : pm, npn = more ? tn - npm * nN : pn;
    const char* nAb = (const char*)(A + (size_t)npm * 256 * lda);
    const char* nBb = (const char*)(Bt + (size_t)npn * 256 * ldb);
    for (int kt = 0; kt < nk; ++kt) {
      const char* cur = lds + stg * G_STAGEB;
      if (kt + 1 < nk) G_DMA(Ab, Bb, stg ^ 1, (kt + 1) * 64);
      else if (more) G_DMA(nAb, nBb, stg ^ 1, 0);
      bf16x8 bfr[4], af[4];
#pragma unroll
      for (int n = 0; n < 4; ++n) bfr[n] = *(const bf16x8*)(cur + bofs0 + n * 2048);
#pragma unroll
      for (int m = 0; m < 4; ++m) af[m] = *(const bf16x8*)(cur + aofs0 + m * 2048);
#pragma unroll
      for (int m = 0; m < 4; ++m)
#pragma unroll
        for (int n = 0; n < 4; ++n) acc[m][n] = __builtin_amdgcn_mfma_f32_16x16x32_bf16(bfr[n], af[m], acc[m][n], 0, 0, 0);
      G_HALF(aofs0, bofs0, 4);
#pragma unroll
      for (int n = 0; n < 4; ++n) bfr[n] = *(const bf16x8*)(cur + bofs1 + n * 2048);
      G_HALF(aofs1, bofs1, 0);
      G_HALF(aofs1, bofs1, 4);
      asm volatile("s_waitcnt vmcnt(0)" ::: "memory");
      __syncthreads();
      stg ^= 1;
    }
    E(acc, pm * 256 + wr * 128, pn * 256 + wc * 64, fr, fq);
    if (!more) break;
    t = tn; pm = npm; pn = npn; Ab = nAb; Bb = nBb;
  }
#undef G_DMA
#undef G_HALF
}

#define SBAR() __builtin_amdgcn_sched_barrier(0)
DEV int crow(int r, int hi) { return (r & 3) + 8 * (r >> 2) + 4 * hi; }
constexpr float ATT_THR = 8.f;
template <int NQK> struct AttnK {
  static constexpr int DQK = NQK * 16, KROWB = DQK * 2, SHM_K = 64 * KROWB, SHM_V = 64 * 128 * 2, SHM = 2 * SHM_V + 2 * SHM_K + 8 * 64 * 4;
  static constexpr float SCALE = NQK == 12 ? 0.07216878364870323f : 0.125f;
  static constexpr int TAILC = NQK == 12 ? 128 : 0;
};
template <int NQK> DEV void partialSM(f32x16& p0, f32x16& p1, float& m_reg, float& mn, float& alpha) {
  constexpr float SC = AttnK<NQK>::SCALE, C = SC * 1.4426950408889634f;
  float pmax = p0[0];
#pragma unroll
  for (int r = 1; r < 16; ++r) pmax = fmaxf(pmax, p0[r]);
#pragma unroll
  for (int r = 0; r < 16; ++r) pmax = fmaxf(pmax, p1[r]);
  { auto rr = __builtin_amdgcn_permlane32_swap(__float_as_uint(pmax), __float_as_uint(pmax), false, false);
    pmax = fmaxf(__uint_as_float(rr[0]), __uint_as_float(rr[1])); }
  if (__builtin_expect(__all(pmax - m_reg <= ATT_THR / SC), 1)) { mn = m_reg; alpha = 1.f; }
  else { mn = fmaxf(m_reg, pmax); alpha = __builtin_amdgcn_exp2f((m_reg - mn) * C); m_reg = mn; }
  const float mnC = -mn * C;
#pragma unroll
  for (int r = 0; r < 16; ++r) p0[r] = fmaf(p0[r], C, mnC);
#pragma unroll
  for (int r = 0; r < 16; ++r) p1[r] = fmaf(p1[r], C, mnC);
#pragma unroll
  for (int r = 0; r < 16; ++r) p0[r] = __builtin_amdgcn_exp2f(p0[r]);
}
DEV void finishSM(f32x16& p0, f32x16& p1, float alpha, float& l_reg, bf16x8& pa0, bf16x8& pa1, bf16x8& pa2, bf16x8& pa3) {
#pragma unroll
  for (int r = 0; r < 16; ++r) p1[r] = __builtin_amdgcn_exp2f(p1[r]);
  float ps = 0;
#pragma unroll
  for (int r = 0; r < 16; ++r) ps += p0[r];
#pragma unroll
  for (int r = 0; r < 16; ++r) ps += p1[r];
  { auto rr = __builtin_amdgcn_permlane32_swap(__float_as_uint(ps), __float_as_uint(ps), false, false);
    ps = __uint_as_float(rr[0]) + __uint_as_float(rr[1]); }
  l_reg = l_reg * alpha + ps;
#define PK4(P, BASE, OUT) do { unsigned a0 = cvtpk(P[BASE + 0], P[BASE + 1]), a1 = cvtpk(P[BASE + 2], P[BASE + 3]);   \
    unsigned b0 = cvtpk(P[BASE + 4], P[BASE + 5]), b1 = cvtpk(P[BASE + 6], P[BASE + 7]);                              \
    auto r0 = __builtin_amdgcn_permlane32_swap(a0, b0, false, false); auto r1 = __builtin_amdgcn_permlane32_swap(a1, b1, false, false); \
    u32x4 w = {r0[0], r1[0], r0[1], r1[1]}; OUT = *reinterpret_cast<bf16x8*>(&w); } while (0)
  PK4(p0, 0, pa0); PK4(p0, 8, pa1); PK4(p1, 0, pa2); PK4(p1, 8, pa3);
#undef PK4
}
template <int NQK> DEV void qkt(f32x16& p0, f32x16& p1, const char* Ks, const bf16x8* qr, int r32, int hi) {
  constexpr int KROWB = AttnK<NQK>::KROWB;
  p0 = f32x16{}; p1 = f32x16{};
#pragma unroll
  for (int d0 = 0; d0 < NQK; ++d0) { const int cb = (d0 * 16 + hi * 8) * 2;
    const bf16x8 b0 = *reinterpret_cast<const bf16x8*>(Ks + r32 * KROWB + (cb ^ ((r32 & 7) << 4)));
    const bf16x8 b1 = *reinterpret_cast<const bf16x8*>(Ks + (32 + r32) * KROWB + (cb ^ ((r32 & 7) << 4)));
    p0 = __builtin_amdgcn_mfma_f32_32x32x16_bf16(b0, qr[d0], p0, 0, 0, 0);
    p1 = __builtin_amdgcn_mfma_f32_32x32x16_bf16(b1, qr[d0], p1, 0, 0, 0); }
}
DEV int v_st(int k, int c) { const int kk = (k & ~0xC) | ((k & 4) << 1) | ((k & 8) >> 1); return ((kk >> 3) * 4 + (c >> 5)) * 512 + ((kk & 7) * 32 + (c & 31)) * 2; }
DEV int v_rd_base(int lane) { return ((lane & 3) << 3) | (((lane >> 2) & 3) << 6) | (((lane >> 4) & 1) << 5) | (((lane >> 5) & 1) << 8); }
constexpr int v_rd_off(int d0, int ks, int half) { return d0 * 512 + ks * 4096 + half * 2048; }
template <int OFF> DEV s16x4 tr_read(int vb) { s16x4 r; asm volatile("ds_read_b64_tr_b16 %0, %1 offset:%2" : "=&v"(r) : "v"(vb), "i"(OFF) : "memory"); return r; }
template <int D0> DEV void pv_one(f32x16& od, int vb, bf16x8 pa0, bf16x8 pa1, bf16x8 pa2, bf16x8 pa3) {
  const s16x4 l0 = tr_read<v_rd_off(D0, 0, 0)>(vb), h0 = tr_read<v_rd_off(D0, 0, 1)>(vb), l1 = tr_read<v_rd_off(D0, 1, 0)>(vb), h1 = tr_read<v_rd_off(D0, 1, 1)>(vb);
  const s16x4 l2 = tr_read<v_rd_off(D0, 2, 0)>(vb), h2 = tr_read<v_rd_off(D0, 2, 1)>(vb), l3 = tr_read<v_rd_off(D0, 3, 0)>(vb), h3 = tr_read<v_rd_off(D0, 3, 1)>(vb);
  asm volatile("s_waitcnt lgkmcnt(0)" ::: "memory"); SBAR();
#define PKV(L, H) (bf16x8){L[0], L[1], L[2], L[3], H[0], H[1], H[2], H[3]}
  od = __builtin_amdgcn_mfma_f32_32x32x16_bf16(pa0, PKV(l0, h0), od, 0, 0, 0);
  od = __builtin_amdgcn_mfma_f32_32x32x16_bf16(pa1, PKV(l1, h1), od, 0, 0, 0);
  od = __builtin_amdgcn_mfma_f32_32x32x16_bf16(pa2, PKV(l2, h2), od, 0, 0, 0);
  od = __builtin_amdgcn_mfma_f32_32x32x16_bf16(pa3, PKV(l3, h3), od, 0, 0, 0);
#undef PKV
}
DEV void pv_d0(f32x16* o, int vb, bf16x8 pa0, bf16x8 pa1, bf16x8 pa2, bf16x8 pa3) {
  pv_one<0>(o[0], vb, pa0, pa1, pa2, pa3); pv_one<1>(o[1], vb, pa0, pa1, pa2, pa3); pv_one<2>(o[2], vb, pa0, pa1, pa2, pa3); pv_one<3>(o[3], vb, pa0, pa1, pa2, pa3);
}

template <int NQK> DEV void qkt_pre(f32x16& p0, f32x16& p1, const char* Ks, const bf16x8* qr, int r32, int hi, float m_reg) {
  constexpr int KROWB = AttnK<NQK>::KROWB;
  f32x16 nm;
#pragma unroll
  for (int r = 0; r < 16; ++r) nm[r] = -m_reg;
#pragma unroll
  for (int d0 = 0; d0 < NQK; ++d0) { const int cb = (d0 * 16 + hi * 8) * 2;
    const bf16x8 b0 = *reinterpret_cast<const bf16x8*>(Ks + r32 * KROWB + (cb ^ ((r32 & 7) << 4)));
    const bf16x8 b1 = *reinterpret_cast<const bf16x8*>(Ks + (32 + r32) * KROWB + (cb ^ ((r32 & 7) << 4)));
    p0 = __builtin_amdgcn_mfma_f32_32x32x16_bf16(b0, qr[d0], d0 == 0 ? nm : p0, 0, 0, 0);
    p1 = __builtin_amdgcn_mfma_f32_32x32x16_bf16(b1, qr[d0], d0 == 0 ? nm : p1, 0, 0, 0); }
}
DEV void partialSM_pre(f32x16& p0, f32x16& p1, float& m_reg, float& alpha, bool first) {
  constexpr float THRL = ATT_THR * 1.4426950408889634f;
  float pmax = p0[0];
#pragma unroll
  for (int r = 1; r < 16; ++r) pmax = fmaxf(pmax, p0[r]);
#pragma unroll
  for (int r = 0; r < 16; ++r) pmax = fmaxf(pmax, p1[r]);
  { auto rr = __builtin_amdgcn_permlane32_swap(__float_as_uint(pmax), __float_as_uint(pmax), false, false);
    pmax = fmaxf(__uint_as_float(rr[0]), __uint_as_float(rr[1])); }
  if (__builtin_expect(!first && __all(pmax <= THRL), 1)) { alpha = 1.f; }
  else { const float delta = first ? pmax : fmaxf(pmax, 0.f); alpha = first ? 1.f : __builtin_amdgcn_exp2f(-delta); m_reg += delta;
#pragma unroll
    for (int r = 0; r < 16; ++r) p0[r] -= delta;
#pragma unroll
    for (int r = 0; r < 16; ++r) p1[r] -= delta; }
#pragma unroll
  for (int r = 0; r < 16; ++r) p0[r] = __builtin_amdgcn_exp2f(p0[r]);
}
template <int NQK, bool PRE = false>
DEV void attn_body(const bf16_t* __restrict__ Qb, int ldq, const bf16_t* __restrict__ Kn, int ldkn, const bf16_t* __restrict__ Kt, int ldkt,
                   const bf16_t* __restrict__ Vh, int ldv, int seq, char* lds, f32x16 (&o)[4]) {
  typedef AttnK<NQK> CF;
  constexpr int SHM_V = CF::SHM_V, SHM_K = CF::SHM_K, KROWB = CF::KROWB, TAILC = CF::TAILC;
  const int tid = tidx(), wid = tid >> 6, lane = tid & 63, r32 = lane & 31, hi = lane >> 5;
  char* V_lds = lds; char* K_lds = lds + 2 * SHM_V;
  float* wsl = (float*)(lds + 2 * SHM_V + 2 * SHM_K) + wid * 64; float* li_l = wsl; float* al_l = wsl + 32;
  float m_reg = PRE ? 0.f : -1e30f, l_reg = 0;
#pragma unroll
  for (int d = 0; d < 4; ++d) o[d] = f32x16{};
  bf16x8 qr[NQK];
  const bf16_t* Qw = Qb + (size_t)(wid * 32 + r32) * ldq + hi * 8;
#pragma unroll
  for (int d0 = 0; d0 < NQK; ++d0) qr[d0] = *(const bf16x8*)(Qw + d0 * 16);
  const int sr = tid >> 4, sc = (tid & 15) * 8, vst0 = v_st(sr, sc), vst1 = v_st(32 + sr, sc);
  const int tr = tid >> 3, tc = (tid & 7) * 8;
  const int kst0 = sr * KROWB + ((sc * 2) ^ ((sr & 7) << 4)), kst1 = (32 + sr) * KROWB + ((sc * 2) ^ ((sr & 7) << 4));
  const int kstt = tr * KROWB + (((TAILC + tc) * 2) ^ ((tr & 7) << 4));
  const int vb0 = (int)(uintptr_t)V_lds + v_rd_base(lane);
  bf16x8 sv0[2], sv1[2], sk0[2], sk1[2], skt[2];
#define SLOAD(i, k0) do { sv0[i] = *(const bf16x8*)(Vh + (size_t)((k0) + sr) * ldv + sc); sv1[i] = *(const bf16x8*)(Vh + (size_t)((k0) + 32 + sr) * ldv + sc); \
    if (NQK == 12) { sk0[i] = *(const bf16x8*)(Kn + (size_t)((k0) + sr) * ldkn + sc); sk1[i] = *(const bf16x8*)(Kn + (size_t)((k0) + 32 + sr) * ldkn + sc); } \
    skt[i] = *(const bf16x8*)(Kt + (size_t)((k0) + tr) * ldkt + tc); } while (0)
#define SWRITE(b, i) do { *(bf16x8*)(V_lds + (b) * SHM_V + vst0) = sv0[i]; *(bf16x8*)(V_lds + (b) * SHM_V + vst1) = sv1[i]; \
    if (NQK == 12) { *(bf16x8*)(K_lds + (b) * SHM_K + kst0) = sk0[i]; *(bf16x8*)(K_lds + (b) * SHM_K + kst1) = sk1[i]; } \
    *(bf16x8*)(K_lds + (b) * SHM_K + kstt) = skt[i]; } while (0)
#define SWAIT() do { if (NQK == 12) asm volatile("s_waitcnt vmcnt(5)" ::: "memory"); else asm volatile("s_waitcnt vmcnt(3)" ::: "memory"); } while (0)
#define RESC(a) do { if (__any((a) < 1.f)) { if (hi == 0) al_l[r32] = (a); asm volatile("s_waitcnt lgkmcnt(0)" ::: "memory"); \
    _Pragma("unroll") for (int d = 0; d < 4; ++d) _Pragma("unroll") for (int r = 0; r < 16; ++r) o[d][r] *= al_l[crow(r, hi)]; } } while (0)
#define QKT(P0, P1, KS) do { if (PRE) qkt_pre<NQK>(P0, P1, KS, qr, r32, hi, m_reg); else qkt<NQK>(P0, P1, KS, qr, r32, hi); } while (0)
#define PSM(P0, P1, MN, AL, FIRST) do { if (PRE) partialSM_pre(P0, P1, m_reg, AL, FIRST); else partialSM<NQK>(P0, P1, m_reg, MN, AL); } while (0)
  f32x16 pA0, pA1, pB0, pB1; float mnA = 0.f, mnB = 0.f, alA, alB; bf16x8 pa0, pa1, pa2, pa3; const int NT = seq / 64;
  __syncthreads();
  SLOAD(0, 0); asm volatile("s_waitcnt vmcnt(0)" ::: "memory"); SWRITE(0, 0); __syncthreads();
  QKT(pA0, pA1, K_lds); PSM(pA0, pA1, mnA, alA, true);
  SLOAD(1, 64); if (2 < NT) SLOAD(0, 128);
  SWAIT(); SWRITE(1, 1); __syncthreads();
  for (int j = 1; j + 1 < NT; j += 2) {
    SBAR(); QKT(pB0, pB1, K_lds + SHM_K);
    finishSM(pA0, pA1, alA, l_reg, pa0, pa1, pa2, pa3); SBAR();
    SLOAD(1, (j + 2) * 64); SBAR();
    pv_d0(o, vb0, pa0, pa1, pa2, pa3); PSM(pB0, pB1, mnB, alB, false);
    __syncthreads(); SWAIT(); SWRITE(0, 0);
    RESC(alB); __syncthreads();
    SBAR(); QKT(pA0, pA1, K_lds);
    finishSM(pB0, pB1, alB, l_reg, pa0, pa1, pa2, pa3); SBAR();
    if (j + 3 < NT) SLOAD(0, (j + 3) * 64); SBAR();
    pv_d0(o, vb0 + SHM_V, pa0, pa1, pa2, pa3); PSM(pA0, pA1, mnA, alA, false);
    __syncthreads(); SWAIT(); SWRITE(1, 1);
    RESC(alA); __syncthreads();
  }
  SBAR(); QKT(pB0, pB1, K_lds + SHM_K);
  finishSM(pA0, pA1, alA, l_reg, pa0, pa1, pa2, pa3); SBAR();
  pv_d0(o, vb0, pa0, pa1, pa2, pa3); PSM(pB0, pB1, mnB, alB, false);
  __syncthreads(); RESC(alB);
  finishSM(pB0, pB1, alB, l_reg, pa0, pa1, pa2, pa3); SBAR();
  pv_d0(o, vb0 + SHM_V, pa0, pa1, pa2, pa3);
  if (hi == 0) li_l[r32] = l_reg; asm volatile("s_waitcnt lgkmcnt(0)" ::: "memory");
#pragma unroll
  for (int r = 0; r < 16; ++r) { const float rl = __builtin_amdgcn_rcpf(li_l[crow(r, hi)]);
#pragma unroll
    for (int d = 0; d < 4; ++d) o[d][r] *= rl; }
#undef SLOAD
#undef SWRITE
#undef SWAIT
#undef RESC
#undef QKT
#undef PSM
}

template <int NQK, bool PRE = false>
DEV void attn_body_s(const bf16_t* __restrict__ Qb, int ldq, const bf16_t* __restrict__ Kn, int ldkn, const bf16_t* __restrict__ Kt, int ldkt,
                     const bf16_t* __restrict__ Vh, int ldv, int seq, char* lds, f32x16 (&o)[4]) {
  typedef AttnK<NQK> CF;
  constexpr int SHM_V = CF::SHM_V, SHM_K = CF::SHM_K, KROWB = CF::KROWB, TAILC = CF::TAILC;
  const int tid = tidx(), wid = tid >> 6, lane = tid & 63, r32 = lane & 31, hi = lane >> 5;
  char* V_lds = lds; char* K_lds = lds + 2 * SHM_V;
  float* wsl = (float*)(lds + 2 * SHM_V + 2 * SHM_K) + wid * 64; float* li_l = wsl; float* al_l = wsl + 32;
  float m_reg = PRE ? 0.f : -1e30f, l_reg = 0;
#pragma unroll
  for (int d = 0; d < 4; ++d) o[d] = f32x16{};
  bf16x8 qr[NQK];
  const bf16_t* Qw = Qb + (size_t)(wid * 32 + r32) * ldq + hi * 8;
#pragma unroll
  for (int d0 = 0; d0 < NQK; ++d0) qr[d0] = *(const bf16x8*)(Qw + d0 * 16);
  const int sr = tid >> 4, sc = (tid & 15) * 8, vst0 = v_st(sr, sc), vst1 = v_st(32 + sr, sc);
  const int tr = tid >> 3, tc = (tid & 7) * 8;
  const int kst0 = sr * KROWB + ((sc * 2) ^ ((sr & 7) << 4)), kst1 = (32 + sr) * KROWB + ((sc * 2) ^ ((sr & 7) << 4));
  const int kstt = tr * KROWB + (((TAILC + tc) * 2) ^ ((tr & 7) << 4));
  const int vb0 = (int)(uintptr_t)V_lds + v_rd_base(lane);
  bf16x8 sv0, sv1, sk0, sk1, skt;
#define SLOAD1(k0) do { sv0 = *(const bf16x8*)(Vh + (size_t)((k0) + sr) * ldv + sc); sv1 = *(const bf16x8*)(Vh + (size_t)((k0) + 32 + sr) * ldv + sc); \
    if (NQK == 12) { sk0 = *(const bf16x8*)(Kn + (size_t)((k0) + sr) * ldkn + sc); sk1 = *(const bf16x8*)(Kn + (size_t)((k0) + 32 + sr) * ldkn + sc); } \
    skt = *(const bf16x8*)(Kt + (size_t)((k0) + tr) * ldkt + tc); } while (0)
#define SWRITE1(b) do { *(bf16x8*)(V_lds + (b) * SHM_V + vst0) = sv0; *(bf16x8*)(V_lds + (b) * SHM_V + vst1) = sv1; \
    if (NQK == 12) { *(bf16x8*)(K_lds + (b) * SHM_K + kst0) = sk0; *(bf16x8*)(K_lds + (b) * SHM_K + kst1) = sk1; } \
    *(bf16x8*)(K_lds + (b) * SHM_K + kstt) = skt; } while (0)
  f32x16 p0, p1; float mn, al; bf16x8 pa0, pa1, pa2, pa3; const int NT = seq / 64;
  __syncthreads();
  SLOAD1(0); SWRITE1(0); SLOAD1(64);
  __syncthreads();
  for (int j = 0; j < NT; ++j) {
    const int b = j & 1;
    if (j + 1 < NT) { SWRITE1(b ^ 1); if (j + 2 < NT) SLOAD1((j + 2) * 64); }
    if (PRE) { qkt_pre<NQK>(p0, p1, K_lds + b * SHM_K, qr, r32, hi, m_reg); partialSM_pre(p0, p1, m_reg, al, j == 0); }
    else { qkt<NQK>(p0, p1, K_lds + b * SHM_K, qr, r32, hi); partialSM<NQK>(p0, p1, m_reg, mn, al); }
    if (__any(al < 1.f)) { if (hi == 0) al_l[r32] = al; asm volatile("s_waitcnt lgkmcnt(0)" ::: "memory");
#pragma unroll
      for (int d = 0; d < 4; ++d)
#pragma unroll
        for (int r = 0; r < 16; ++r) o[d][r] *= al_l[crow(r, hi)]; }
    finishSM(p0, p1, al, l_reg, pa0, pa1, pa2, pa3);
    pv_d0(o, vb0 + b * SHM_V, pa0, pa1, pa2, pa3);
    __syncthreads();
  }
  if (hi == 0) li_l[r32] = l_reg; asm volatile("s_waitcnt lgkmcnt(0)" ::: "memory");
#pragma unroll
  for (int r = 0; r < 16; ++r) { const float rl = __builtin_amdgcn_rcpf(li_l[crow(r, hi)]);
#pragma unroll
    for (int d = 0; d < 4; ++d) o[d][r] *= rl; }
#undef SLOAD1
#undef SWRITE1
}

constexpr int H_RS = 272;
constexpr int H_TS = 144;
DEV void hgrn_prep(const bf16_t* __restrict__ z, const float* __restrict__ hg_lb, int tok0, int hh, int dir, int k, int qq, float* tot,
                   float (&cum)[16], float (&kk)[16], float& total, float& ref, const bf16_t (&fraw)[16]) {
  const int ch = hh * 128 + k;
  const float a0 = hg_lb[dir * 1024 + ch], a1 = hg_lb[dir * 1024 + 512 + ch];
  const float lb = 1.f / (1.f + __expf(a1 - a0));
#pragma unroll
  for (int i = 0; i < 16; ++i) { const float fp = bf2f(fraw[i]); const float sg = sigmoidf_(fp);
    cum[i] = __logf(lb + (1.f - lb) * sg); kk[i] = (1.f - lb) * (1.f - sg); }
  if (dir == 0) {
#pragma unroll
    for (int i = 1; i < 16; ++i) cum[i] += cum[i - 1];
    tot[qq * 128 + k] = cum[15];
  } else {
#pragma unroll
    for (int i = 14; i >= 0; --i) cum[i] += cum[i + 1];
    tot[qq * 128 + k] = cum[0];
  }
  __syncthreads();
  const float t0 = tot[k], t1 = tot[128 + k], t2 = tot[256 + k], t3 = tot[384 + k];
  total = (t0 + t1) + (t2 + t3);
  float offs;
  if (dir == 0) { offs = (qq > 0 ? t0 : 0.f) + (qq > 1 ? t1 : 0.f) + (qq > 2 ? t2 : 0.f); ref = t0 + t1; }
  else { offs = (qq < 3 ? t3 : 0.f) + (qq < 2 ? t2 : 0.f) + (qq < 1 ? t1 : 0.f); ref = t2 + t3; }
#pragma unroll
  for (int i = 0; i < 16; ++i) cum[i] += offs;
}
DEV void hgrn_load16(const bf16_t* __restrict__ p, bf16_t (&r)[16]) {
#pragma unroll
  for (int i = 0; i < 16; ++i) r[i] = p[(size_t)i * ZLD];
}
DEV void pack16_store(char* dst, const float (&v)[16]) {
  u32x4 w0, w1;
  w0.x = cvtpk(v[0], v[1]); w0.y = cvtpk(v[2], v[3]); w0.z = cvtpk(v[4], v[5]); w0.w = cvtpk(v[6], v[7]);
  w1.x = cvtpk(v[8], v[9]); w1.y = cvtpk(v[10], v[11]); w1.z = cvtpk(v[12], v[13]); w1.w = cvtpk(v[14], v[15]);
  *(u32x4*)dst = w0; *(u32x4*)(dst + 16) = w1;
}
DEV void hgrn_stepA(char* lds, const bf16_t* __restrict__ z, const float* __restrict__ hg_lb, bf16_t* __restrict__ ST, float* __restrict__ HD) {
  const int tid = tidx(), wid = tid >> 6, lane = tid & 63, fr = lane & 15, fq = lane >> 4, k = tid & 127, qq = tid >> 7;
  char* KdT = lds;
  char* VT = lds + 128 * H_TS;
  float* tot = (float*)(lds + 2 * 128 * H_TS);
  bf16_t pf[16], pv[16];
#define HA_LOAD(U) do { const int j_ = (U) & 127, r_ = (U) >> 7, d_ = r_ & 1, h_ = (r_ >> 1) & 3, b_ = r_ >> 3; \
    const bf16_t* zb_ = z + (size_t)(b_ * SEQ + j_ * 64 + qq * 16) * ZLD + h_ * 128 + k; hgrn_load16(zb_ + 512 + d_ * 512, pf); hgrn_load16(zb_ + 1536, pv); } while (0)
  { const int u0 = vblock(); if (u0 < 4096) HA_LOAD(u0); }
  for (int u = vblock(); u < 4096; u += gridDim.x) {
    const int j = u & 127, rest = u >> 7, dir = rest & 1, hh = (rest >> 1) & 3, b = rest >> 3;
    const int tok0 = b * SEQ + j * 64;
    float cum[16], kk[16], total, ref;
    bf16_t cf[16], cv[16];
#pragma unroll
    for (int i = 0; i < 16; ++i) { cf[i] = pf[i]; cv[i] = pv[i]; }
    if (u + (int)gridDim.x < 4096) HA_LOAD(u + (int)gridDim.x);
    __syncthreads();
    hgrn_prep(z, hg_lb, tok0, hh, dir, k, qq, tot, cum, kk, total, ref, cf);
    float kd[16], vv[16];
#pragma unroll
    for (int i = 0; i < 16; ++i) { kd[i] = kk[i] * __expf(total - cum[i]); vv[i] = bf2f(cv[i]); }
    pack16_store(KdT + k * H_TS + qq * 32, kd);
    pack16_store(VT + k * H_TS + qq * 32, vv);
    if (qq == 0) HD[(size_t)u * 128 + k] = __expf(total);
    __syncthreads();
    f32x4 acc[8];
#pragma unroll
    for (int m = 0; m < 8; ++m) acc[m] = (f32x4){0.f, 0.f, 0.f, 0.f};
#pragma unroll
    for (int ks = 0; ks < 2; ++ks) { const bf16x8 bv = *(const bf16x8*)(VT + (wid * 16 + fr) * H_TS + ks * 64 + fq * 16);
#pragma unroll
      for (int m = 0; m < 8; ++m) { const bf16x8 ak = *(const bf16x8*)(KdT + (m * 16 + fr) * H_TS + ks * 64 + fq * 16);
        acc[m] = __builtin_amdgcn_mfma_f32_16x16x32_bf16(ak, bv, acc[m], 0, 0, 0); } }
    bf16_t* sp = ST + (size_t)u * 16384 + (wid * 16 + fr) * 128 + 4 * fq;
#pragma unroll
    for (int m = 0; m < 8; ++m) { u32x2 w; w.x = cvtpk(acc[m][0], acc[m][1]); w.y = cvtpk(acc[m][2], acc[m][3]); *(u32x2*)(sp + m * 16) = w; }
  }
}
DEV void hgrn_stepB(bf16_t* __restrict__ ST, const float* __restrict__ HD) {
  for (int gid = blockIdx.x * NTHR + tidx(); gid < 32 * 4096; gid += gridDim.x * NTHR) {
    const int seq = gid >> 12, e = (gid & 4095) * 4, kq = e & 127, dir = seq & 1;
    float S0 = 0.f, S1 = 0.f, S2 = 0.f, S3 = 0.f;
    for (int s0 = 0; s0 < 128; s0 += 8) {
      u32x2 uu[8]; f32x4 dd[8];
#pragma unroll
      for (int i = 0; i < 8; ++i) { const int j = dir ? 127 - (s0 + i) : (s0 + i); const size_t un = (size_t)seq * 128 + j;
        uu[i] = *(const u32x2*)(ST + un * 16384 + e); dd[i] = *(const f32x4*)(HD + un * 128 + kq); }
#pragma unroll
      for (int i = 0; i < 8; ++i) { const int j = dir ? 127 - (s0 + i) : (s0 + i); const size_t un = (size_t)seq * 128 + j;
        u32x2 w; w.x = cvtpk(S0, S1); w.y = cvtpk(S2, S3); *(u32x2*)(ST + un * 16384 + e) = w;
        S0 = dd[i][0] * S0 + __uint_as_float(uu[i].x << 16); S1 = dd[i][1] * S1 + __uint_as_float(uu[i].x & 0xffff0000u);
        S2 = dd[i][2] * S2 + __uint_as_float(uu[i].y << 16); S3 = dd[i][3] * S3 + __uint_as_float(uu[i].y & 0xffff0000u); }
    }
  }
}
DEV void hgrn_stepC(char* lds, const bf16_t* __restrict__ z, const float* __restrict__ hg_lb, const float* __restrict__ hg_norm,
                    const bf16_t* __restrict__ ST, bf16_t* __restrict__ mix) {
  const int tid = tidx(), wid = tid >> 6, lane = tid & 63, fr = lane & 15, fq = lane >> 4, k = tid & 127, qq = tid >> 7;
  const int mt = wid & 3, chh = wid >> 2;
  char* Qd = lds; char* Kd = lds + 64 * H_RS; char* Qs = lds + 128 * H_RS;
  char* VT = lds + 192 * H_RS;
  char* Pm = VT + 128 * H_TS;
  float* tot = (float*)(Pm + 64 * H_TS);
  float* ssq = tot + 512;
  bf16_t pq[16], pv[16], pf0[16], pf1[16];
#define HC_LOAD(U) do { const int j_ = (U) & 127, h_ = ((U) >> 7) & 3, b_ = (U) >> 9; const bf16_t* zb_ = z + (size_t)(b_ * SEQ + j_ * 64 + qq * 16) * ZLD + h_ * 128 + k; \
    hgrn_load16(zb_, pq); hgrn_load16(zb_ + 512, pf0); hgrn_load16(zb_ + 1024, pf1); hgrn_load16(zb_ + 1536, pv); } while (0)
  { const int u0 = vblock(); if (u0 < 2048) HC_LOAD(u0); }
  for (int u = vblock(); u < 2048; u += gridDim.x) {
    const int j = u & 127, hh = (u >> 7) & 3, b = u >> 9;
    const int tok0 = b * SEQ + j * 64;
    bf16_t cq[16], cv[16], cf0[16], cf1[16];
#pragma unroll
    for (int i = 0; i < 16; ++i) { cq[i] = pq[i]; cv[i] = pv[i]; cf0[i] = pf0[i]; cf1[i] = pf1[i]; }
    if (u + (int)gridDim.x < 2048) HC_LOAD(u + (int)gridDim.x);
    f32x4 ao[4];
#pragma unroll
    for (int n = 0; n < 4; ++n) ao[n] = (f32x4){0.f, 0.f, 0.f, 0.f};
    for (int dir = 0; dir < 2; ++dir) {
      float cum[16], kk[16], total, ref;
      bf16_t cf[16];
#pragma unroll
      for (int i = 0; i < 16; ++i) cf[i] = dir ? cf1[i] : cf0[i];
      bf16x8 sfr[16];
      { const int un_ = ((b * 4 + hh) * 2 + dir) * 128 + j; const bf16_t* sp_ = ST + (size_t)un_ * 16384 + (size_t)(chh * 64 + fr) * 128 + fq * 8;
#pragma unroll
        for (int ks = 0; ks < 4; ++ks)
#pragma unroll
          for (int n = 0; n < 4; ++n) sfr[ks * 4 + n] = *(const bf16x8*)(sp_ + n * 16 * 128 + ks * 32); }
      __syncthreads();
      hgrn_prep(z, hg_lb, tok0, hh, dir, k, qq, tot, cum, kk, total, ref, cf);
#pragma unroll
      for (int i = 0; i < 16; ++i) { const int s = qq * 16 + i; const float qv = siluf_(bf2f(cq[i])) * 0.08838834764831845f;
        *(bf16_t*)(Qd + s * H_RS + k * 2) = f2bf(qv * __expf(cum[i] - ref));
        *(bf16_t*)(Kd + s * H_RS + k * 2) = f2bf(kk[i] * __expf(ref - cum[i]));
        *(bf16_t*)(Qs + s * H_RS + k * 2) = f2bf(qv * __expf(cum[i])); }
      if (dir == 0) { float vv[16];
#pragma unroll
        for (int i = 0; i < 16; ++i) vv[i] = bf2f(cv[i]);
        pack16_store(VT + k * H_TS + qq * 32, vv); }
      __syncthreads();
      f32x4 sc[2] = {(f32x4){0.f, 0.f, 0.f, 0.f}, (f32x4){0.f, 0.f, 0.f, 0.f}};
#pragma unroll
      for (int ks = 0; ks < 4; ++ks) { const bf16x8 qf = *(const bf16x8*)(Qd + (mt * 16 + fr) * H_RS + ks * 64 + fq * 16);
#pragma unroll
        for (int n = 0; n < 2; ++n) { const bf16x8 kf = *(const bf16x8*)(Kd + (chh * 32 + n * 16 + fr) * H_RS + ks * 64 + fq * 16);
          sc[n] = __builtin_amdgcn_mfma_f32_16x16x32_bf16(kf, qf, sc[n], 0, 0, 0); } }
      const int trow = mt * 16 + fr;
#pragma unroll
      for (int n = 0; n < 2; ++n) { float pv[4];
#pragma unroll
        for (int e = 0; e < 4; ++e) { const int s = chh * 32 + n * 16 + 4 * fq + e; const bool keep = dir == 0 ? (s <= trow) : (s >= trow); pv[e] = keep ? sc[n][e] : 0.f; }
        u32x2 w; w.x = cvtpk(pv[0], pv[1]); w.y = cvtpk(pv[2], pv[3]); *(u32x2*)(Pm + trow * H_TS + (chh * 32 + n * 16 + 4 * fq) * 2) = w; }
      const int un = ((b * 4 + hh) * 2 + dir) * 128 + j;
      const bf16_t* sp = ST + (size_t)un * 16384 + (size_t)(chh * 64 + fr) * 128 + fq * 8;
#pragma unroll
      for (int ks = 0; ks < 4; ++ks) { const bf16x8 qf = *(const bf16x8*)(Qs + (mt * 16 + fr) * H_RS + ks * 64 + fq * 16);
#pragma unroll
        for (int n = 0; n < 4; ++n) ao[n] = __builtin_amdgcn_mfma_f32_16x16x32_bf16(sfr[ks * 4 + n], qf, ao[n], 0, 0, 0); }
      __syncthreads();
#pragma unroll
      for (int ks = 0; ks < 2; ++ks) { const bf16x8 pf = *(const bf16x8*)(Pm + (mt * 16 + fr) * H_TS + ks * 64 + fq * 16);
#pragma unroll
        for (int n = 0; n < 4; ++n) { const bf16x8 vf = *(const bf16x8*)(VT + (chh * 64 + n * 16 + fr) * H_TS + ks * 64 + fq * 16);
          ao[n] = __builtin_amdgcn_mfma_f32_16x16x32_bf16(vf, pf, ao[n], 0, 0, 0); } }
    }
    float ss = 0.f;
#pragma unroll
    for (int n = 0; n < 4; ++n) ss += ao[n][0] * ao[n][0] + ao[n][1] * ao[n][1] + ao[n][2] * ao[n][2] + ao[n][3] * ao[n][3];
    ss += shfl_xor_f(ss, 16); ss += shfl_xor_f(ss, 32);
    if (fq == 0) ssq[chh * 64 + mt * 16 + fr] = ss;
    __syncthreads();
    const float rstd = rsqrtf((ssq[mt * 16 + fr] + ssq[64 + mt * 16 + fr]) * (1.f / 128.f) + EPS);
    const int tok = tok0 + mt * 16 + fr;
#pragma unroll
    for (int n = 0; n < 4; ++n) { const int v0 = chh * 64 + n * 16 + 4 * fq;
      const f32x4 gn = *(const f32x4*)(hg_norm + hh * 128 + v0);
      const u32x2 gz = *(const u32x2*)(z + (size_t)tok * ZLD + 2048 + hh * 128 + v0);
      const float g0 = siluf_(__uint_as_float(gz.x << 16)), g1 = siluf_(__uint_as_float(gz.x & 0xffff0000u)), g2 = siluf_(__uint_as_float(gz.y << 16)), g3 = siluf_(__uint_as_float(gz.y & 0xffff0000u));
      u32x2 w; w.x = cvtpk(ao[n][0] * rstd * gn[0] * g0, ao[n][1] * rstd * gn[1] * g1); w.y = cvtpk(ao[n][2] * rstd * gn[2] * g2, ao[n][3] * rstd * gn[3] * g3);
      *(u32x2*)(mix + (size_t)tok * DM + hh * 128 + v0) = w; }
  }
}

DEV void mla_phase(char* lds, const bf16_t* __restrict__ QF, const bf16_t* __restrict__ KVF, const bf16_t* __restrict__ Z, bf16_t* __restrict__ mix) {
  const int wid = tidx() >> 6, lane = tidx() & 63, r32 = lane & 31, hi = lane >> 5;
  for (int u = vblock(); u < 512; u += gridDim.x) {
    const int bh = u >> 5, qb = u & 31, b = bh >> 2, h = bh & 3;
    const size_t t0 = (size_t)b * SEQ;
    f32x16 o[4];
    attn_body_s<12, true>(QF + (t0 + qb * 256) * 768 + h * 192, 768, KVF + t0 * 1024 + h * 256, 1024, Z + t0 * ZLD + 3200, ZLD, KVF + t0 * 1024 + h * 256 + 128, 1024, SEQ, lds, o);
    bf16_t* op = mix + (t0 + qb * 256 + wid * 32) * DM + 512 + h * 128 + r32; asm volatile("" : "+v"(op));
#pragma unroll
    for (int r = 0; r < 16; ++r) { const int orow = crow(r, hi);
#pragma unroll
      for (int d0 = 0; d0 < 4; ++d0) op[(size_t)orow * DM + d0 * 32] = f2bf(o[d0][r]); }
  }
}
DEV void diff_phase(char* lds, const bf16_t* __restrict__ QKV, const Params& p, float* __restrict__ scr, bf16_t* __restrict__ mix) {
  const int wid = tidx() >> 6, lane = tidx() & 63, r32 = lane & 31, hi = lane >> 5;
  float d1 = p.lq1[lane] * p.lk1[lane], d2 = p.lq2[lane] * p.lk2[lane];
#pragma unroll
  for (int o = 32; o >= 1; o >>= 1) { d1 += shfl_xor_f(d1, o); d2 += shfl_xor_f(d2, o); }
  const float lam = __expf(d1) - __expf(d2) + LAMBDA_INIT;
  float* myscr = scr + (size_t)blockIdx.x * 32768 + wid * 4096 + lane;
  for (int u = vblock(); u < 1024; u += gridDim.x) {
    const int bh = u >> 5, qb = u & 31, b = bh >> 3, h = bh & 7;
    const size_t t0 = (size_t)b * SEQ;
    const bf16_t* base = QKV + t0 * 3072;
    f32x16 o[4];
#pragma unroll 1
    for (int c = 0; c < 2; ++c) {
      attn_body<4, true>(base + (size_t)(qb * 256) * 3072 + h * 128 + c * 64, 3072, nullptr, 0, base + 1024 + h * 128 + c * 64, 3072, base + 2048 + h * 128, 3072, SEQ, lds, o);
      if (c == 0) {
        float* wrscr = myscr; asm volatile("" : "+v"(wrscr));
#pragma unroll
        for (int d0 = 0; d0 < 4; ++d0)
#pragma unroll
          for (int r = 0; r < 16; ++r) wrscr[(d0 * 16 + r) * 64] = o[d0][r];
      }
    }
    float ss[16];
#pragma unroll
    for (int r = 0; r < 16; ++r) ss[r] = 0.f;
    const float* rdscr = myscr; asm volatile("" : "+v"(rdscr));
#pragma unroll
    for (int d0 = 0; d0 < 4; ++d0)
#pragma unroll
      for (int r = 0; r < 16; ++r) { const float v = rdscr[(d0 * 16 + r) * 64] - lam * o[d0][r]; o[d0][r] = v; ss[r] += v * v; }
#pragma unroll
    for (int r = 0; r < 16; ++r) {
#pragma unroll
      for (int s = 16; s >= 1; s >>= 1) ss[r] += shfl_xor_f(ss[r], s);
      ss[r] = rsqrtf(ss[r] * (1.f / 128.f) + EPS) * (1.f - LAMBDA_INIT); }
    bf16_t* op = mix + (t0 + qb * 256 + wid * 32) * DM + h * 128 + r32; asm volatile("" : "+v"(op));
#pragma unroll
    for (int d0 = 0; d0 < 4; ++d0) { const float gn = p.diff_norm[d0 * 32 + r32];
#pragma unroll
      for (int r = 0; r < 16; ++r) op[(size_t)crow(r, hi) * DM + d0 * 32] = f2bf(o[d0][r] * ss[r] * gn); }
  }
}


__global__ void __launch_bounds__(NTHR) fwd_megakernel(Params p) {
  extern __shared__ __attribute__((aligned(16))) char lds[];
  cg::grid_group grid = cg::this_grid();
  __shared__ __attribute__((aligned(16))) unsigned xb_words[4];
  if (threadIdx.x < 4) xb_words[threadIdx.x] = 0u;
  __syncthreads();
  (void)xcd_barrier_post((unsigned*)(p.ws + WS_BAR), (volatile LAS unsigned*)&xb_words[0]);
  unsigned char* ws = p.ws;
  bf16_t* W_in0 = (bf16_t*)(ws + WS_WIN0); bf16_t* W_uq = (bf16_t*)(ws + WS_WUQ); bf16_t* W_ukv = (bf16_t*)(ws + WS_WUKV); bf16_t* W_out0 = (bf16_t*)(ws + WS_WOUT0);
  bf16_t* W_gu = (bf16_t*)(ws + WS_WGU); bf16_t* W_dn = (bf16_t*)(ws + WS_WDN); bf16_t* W_cin = (bf16_t*)(ws + WS_WCIN); bf16_t* W_cout = (bf16_t*)(ws + WS_WCOUT);
  float* COS = (float*)(ws + WS_COS); float* SIN = (float*)(ws + WS_SIN); float* HD = (float*)(ws + WS_HD);
  bf16_t* HB = (bf16_t*)(ws + WS_HB); bf16_t* Z = (bf16_t*)(ws + WS_Z); bf16_t* CN = (bf16_t*)(ws + WS_CN); bf16_t* QF = (bf16_t*)(ws + WS_QF); bf16_t* KVF = (bf16_t*)(ws + WS_KVF);
  bf16_t* ST = (bf16_t*)p.out;
  float* SCR = (float*)(ws + WS_SCR);
  constexpr size_t WGU_E = (size_t)5632 * 1024, WDN_E = (size_t)1024 * 2816;

#define GSYNC() do { XcdBarrier xb_; xb_.bar = (unsigned*)(p.ws + WS_BAR); xb_.x = xb_xcc_id(); xb_.st = (volatile LAS unsigned*)&xb_words[0]; xcd_barrier(xb_); } while (0)
  {
    const int gtid = blockIdx.x * NTHR + tidx(), gsz = gridDim.x * NTHR;
    for (int i = gtid; i < SEQ * 32; i += gsz) { const int pos = i >> 5, jf = i & 31; const float ang = (float)pos * p.inv[jf];
      const double a = (double)ang; const double n = rint(a * 0.15915494309189535); const float r = (float)(a - n * 6.283185307179586);
      COS[i] = __cosf(r); SIN[i] = __sinf(r); }
    for (int i = gtid; i < 64 * 1024; i += gsz) W_in0[(size_t)3264 * 1024 + i] = 0;
    int xrot = 0;
    xpose_job(lds, p.ab_w_in, 1024, 3264, W_in0, 0, xrot);
    xpose_job(lds, p.w_uq, 384, 768, W_uq, 0, xrot);
    xpose_job(lds, p.w_ukv, 256, 1024, W_ukv, 0, xrot);
    xpose_job(lds, p.ab_w_out, 1024, 1024, W_out0, 0, xrot);
    for (int l = 0; l < 2; ++l) {
      xpose_job(lds, p.w_gate + (size_t)l * 1024 * FH, 1024, FH, W_gu + l * WGU_E, 1, xrot);
      xpose_job(lds, p.w_up + (size_t)l * 1024 * FH, 1024, FH, W_gu + l * WGU_E, 2, xrot);
      xpose_job(lds, p.w_down + (size_t)l * FH * 1024, FH, 1024, W_dn + l * WDN_E, 0, xrot);
    }
    xpose_job(lds, p.c_w_in, 1024, 3072, W_cin, 0, xrot);
    xpose_job(lds, p.c_w_out, 1024, 1024, W_cout, 0, xrot);
    rms_rows_bf16(p.x, p.norm_attn, HB);
  }
  asm volatile("s_waitcnt vmcnt(0)" ::: "memory"); grid.sync();
  { EpiStore e{Z, ZLD, 1, COS, SIN}; gemm_phase(lds, HB, 1024, W_in0, 1024, 1024, 13, 128 * 13, e); }
  GSYNC();
  cnorm_rows(Z, p.q_norm, p.kv_norm, CN);
  hgrn_stepA(lds, Z, p.hg_lb, ST, HD);
  GSYNC();
  hgrn_stepB(ST, HD);
  { EpiStore e{QF, 768, 2, COS, SIN}; gemm_phase<EpiStore, false>(lds, CN, 640, W_uq, 384, 384, 3, 128 * 3, e); }
  { EpiStore e{KVF, 1024, 0, COS, SIN}; gemm_phase<EpiStore, false>(lds, CN + 384, 640, W_ukv, 256, 256, 4, 128 * 4, e); }
  GSYNC();
  mla_phase(lds, QF, KVF, Z, HB);
  hgrn_stepC(lds, Z, p.hg_lb, p.hg_norm, ST, HB);
  GSYNC();
  { EpiResid e{p.x, p.out}; gemm_phase(lds, HB, 1024, W_out0, 1024, 1024, 4, 128 * 4, e); }
  GSYNC();
  for (int layer = 0; layer < 2; ++layer) {
    if (layer == 1) {
      rms_rows_bf16(p.out, p.norm_attn + 1024, HB);
      GSYNC();
      { EpiStore e{Z, 3072, 3, COS, SIN}; gemm_phase(lds, HB, 1024, W_cin, 1024, 1024, 12, 128 * 12, e); }
      GSYNC();
      diff_phase(lds, Z, p, SCR, HB);
      GSYNC();
      { EpiResid e{p.out, p.out}; gemm_phase(lds, HB, 1024, W_cout, 1024, 1024, 4, 128 * 4, e); }
      GSYNC();
    }
    rms_rows_bf16(p.out, p.norm_ffn + layer * 1024, HB);
    GSYNC();
    { EpiSwiglu e{Z}; gemm_phase(lds, HB, 1024, W_gu + layer * WGU_E, 1024, 1024, 22, 128 * 22, e); }
    GSYNC();
    { EpiResid e{p.out, p.out}; gemm_phase(lds, Z, FH, W_dn + layer * WDN_E, FH, FH, 4, 128 * 4, e); }
    GSYNC();
  }
  rms_rows_f32(p.out, p.final_norm);
}

extern "C" void kernel_launch(void* const* d_in, const int* in_sizes, int n_in, void* d_out, int out_size, void* d_ws, size_t ws_size, hipStream_t stream) {
  static int grid_blocks = 0;
  if (grid_blocks == 0) {
    if (n_in != 22 || out_size != T_TOK * DM || ws_size < WS_END) { fprintf(stderr, "kernel_launch: unexpected shapes n_in %d out %d ws %zu (need %zu)\n", n_in, out_size, ws_size, (size_t)WS_END); grid_blocks = -1; return; }
    int dev = 0, cus = 0, per_cu = 0;
    hipGetDevice(&dev);
    hipDeviceGetAttribute(&cus, hipDeviceAttributeMultiprocessorCount, dev);
    if (hipFuncSetAttribute((const void*)fwd_megakernel, hipFuncAttributeMaxDynamicSharedMemorySize, LDS_BYTES) != hipSuccess) { fprintf(stderr, "kernel_launch: hipFuncSetAttribute failed\n"); grid_blocks = -1; return; }
    if (hipOccupancyMaxActiveBlocksPerMultiprocessor(&per_cu, (const void*)fwd_megakernel, NTHR, LDS_BYTES) != hipSuccess || per_cu < 1) { fprintf(stderr, "kernel_launch: occupancy query gives %d\n", per_cu); per_cu = 1; }
    (void)hipGetLastError();
    grid_blocks = cus;
    if (grid_blocks % 8) grid_blocks -= grid_blocks % 8;
  }
  if (grid_blocks < 0) return;
  Params p{};
  const float** pf = (const float**)&p;
  for (int i = 0; i < 22; ++i) pf[i] = (const float*)d_in[i];
  p.out = (float*)d_out; p.ws = (unsigned char*)d_ws;
  for (int j = 0; j < 32; ++j) p.inv[j] = (float)(1.0 / pow(10000.0, (double)j / 32.0));
  if (hipMemsetAsync((char*)d_ws + WS_BAR, 0, XCD_BAR_WORDS * 4, stream) != hipSuccess) { fprintf(stderr, "kernel_launch: memset of the barrier words failed\n"); return; }
  void* args[] = {&p};
  hipError_t e = hipLaunchCooperativeKernel((const void*)fwd_megakernel, dim3(grid_blocks), dim3(NTHR), args, LDS_BYTES, stream);
  if (e != hipSuccess) fprintf(stderr, "kernel_launch: cooperative launch failed: %s (grid %d)\n", hipGetErrorString(e), grid_blocks);
}
```

```cpp
#include <hip/hip_runtime.h>
#include <hip/hip_cooperative_groups.h>
#include <cstdio>
#include <cstdint>
#include <cmath>
namespace cg = cooperative_groups;

typedef unsigned short bf16_t;
typedef short bf16x8 __attribute__((ext_vector_type(8)));
typedef short s16x4 __attribute__((ext_vector_type(4)));
typedef float f32x4 __attribute__((ext_vector_type(4)));
typedef float f32x16 __attribute__((ext_vector_type(16)));
typedef unsigned u32x4 __attribute__((ext_vector_type(4)));
typedef unsigned u32x2 __attribute__((ext_vector_type(2)));
#define DEV __device__ __forceinline__

constexpr int T_TOK = 32768, SEQ = 8192, NB = 4, DM = 1024, FH = 2816;
constexpr int ZLD = 3328;
constexpr int NTHR = 512;
constexpr float EPS = 1e-6f;
constexpr float LAMBDA_INIT = 0.35550906759096926f;

constexpr size_t al256(size_t x) { return (x + 255) / 256 * 256; }
constexpr size_t WS_WIN0 = 0;
constexpr size_t WS_WUQ = WS_WIN0 + al256((size_t)ZLD * 1024 * 2);
constexpr size_t WS_WUKV = WS_WUQ + al256((size_t)768 * 384 * 2);
constexpr size_t WS_WOUT0 = WS_WUKV + al256((size_t)1024 * 256 * 2);
constexpr size_t WS_WGU = WS_WOUT0 + al256((size_t)1024 * 1024 * 2);
constexpr size_t WS_WDN = WS_WGU + 2 * al256((size_t)5632 * 1024 * 2);
constexpr size_t WS_WCIN = WS_WDN + 2 * al256((size_t)1024 * 2816 * 2);
constexpr size_t WS_WCOUT = WS_WCIN + al256((size_t)3072 * 1024 * 2);
constexpr size_t WS_COS = WS_WCOUT + al256((size_t)1024 * 1024 * 2);
constexpr size_t WS_SIN = WS_COS + al256((size_t)8192 * 32 * 4);
constexpr size_t WS_HD = WS_SIN + al256((size_t)8192 * 32 * 4);
constexpr size_t WS_FLAG = WS_HD + al256((size_t)4096 * 128 * 4);
constexpr size_t WS_BAR = WS_FLAG + 4096;
constexpr size_t WS_HB = WS_BAR + 16384;
constexpr size_t WS_Z = WS_HB + al256((size_t)T_TOK * 1024 * 2);
constexpr size_t WS_CN = WS_Z + al256((size_t)T_TOK * ZLD * 2);
constexpr size_t WS_QF = WS_CN + al256((size_t)T_TOK * 640 * 2);
constexpr size_t WS_KVF = WS_QF + al256((size_t)T_TOK * 768 * 2);
constexpr size_t WS_END = WS_KVF + al256((size_t)T_TOK * 1024 * 2);
constexpr size_t WS_SCR = WS_CN;

constexpr int LDS_BYTES = 131072;

struct Params {
  const float* x; const float* norm_attn; const float* norm_ffn; const float* w_gate; const float* w_up; const float* w_down;
  const float* ab_w_in; const float* hg_lb; const float* hg_norm; const float* q_norm; const float* w_uq; const float* kv_norm;
  const float* w_ukv; const float* ab_w_out; const float* c_w_in; const float* lq1; const float* lk1; const float* lq2; const float* lk2;
  const float* diff_norm; const float* c_w_out; const float* final_norm;
  float* out; unsigned char* ws;
  float inv[32];
};

DEV float bf2f(bf16_t h) { return __uint_as_float(((unsigned)h) << 16); }
typedef float f32x2_t __attribute__((ext_vector_type(2))); typedef __bf16 bf16x2_t __attribute__((ext_vector_type(2)));
DEV unsigned cvtpk(float lo, float hi) { f32x2_t v = {lo, hi}; bf16x2_t b = __builtin_convertvector(v, bf16x2_t); return __builtin_bit_cast(unsigned, b); }
DEV bf16_t f2bf(float f) { return (bf16_t)(cvtpk(f, f) & 0xffffu); }
DEV float sigmoidf_(float x) { return __builtin_amdgcn_rcpf(1.f + __expf(-x)); }
DEV float siluf_(float x) { return x * __builtin_amdgcn_rcpf(1.f + __expf(-x)); }
DEV float shfl_xor_f(float v, int o) { int self = (int)__builtin_amdgcn_mbcnt_hi(~0u, __builtin_amdgcn_mbcnt_lo(~0u, 0u)); asm volatile("" : "+v"(self));
  return __int_as_float(__builtin_amdgcn_ds_bpermute((self ^ o) << 2, __float_as_int(v))); }
DEV int tidx() { int t = threadIdx.x; asm volatile("" : "+v"(t)); return t; }
DEV int vblock() { return (blockIdx.x & 7) * (gridDim.x >> 3) + (blockIdx.x >> 3); }

#define XB_TMO      128
#define XB_XCNT(j)  (256  + 64 * (j))
#define XB_XSUB(j)  (1280 + 64 * (j))
#define XB_XGEN(j)  (2304 + 64 * (j))
#define XB_TOP      3328
#define XB_TOPGEN   3392
#define XCD_BAR_WORDS 3456
#define XB_SPIN_CAP (1u << 18)
#define LAS __attribute__((address_space(3)))

__device__ __forceinline__ unsigned xb_ld(unsigned* p)              { return __hip_atomic_load(p, __ATOMIC_RELAXED, __HIP_MEMORY_SCOPE_AGENT); }
__device__ __forceinline__ unsigned xb_add(unsigned* p, unsigned v) { return __hip_atomic_fetch_add(p, v, __ATOMIC_RELAXED, __HIP_MEMORY_SCOPE_AGENT); }
__device__ __forceinline__ unsigned xb_xcc_id() { return (unsigned)__builtin_amdgcn_s_getreg((3 << 11) | 20) & 0xFu; }
#define XB_SPIN(cond, bar) do { unsigned _sp = 0; while (cond) { __builtin_amdgcn_s_sleep(1); \
    if ((++_sp & 255u) == 0u) { if (xb_ld(&(bar)[XB_TMO])) break; if (_sp > XB_SPIN_CAP) { atomicAdd(&(bar)[XB_TMO], 1u); break; } } } } while (0)

struct XcdBarrier {
    unsigned* bar; unsigned x;
    volatile LAS unsigned* st;
};

__device__ __forceinline__ XcdBarrier xcd_barrier_post(unsigned* bar, volatile LAS unsigned* st) {
    XcdBarrier b; b.bar = bar; b.x = xb_xcc_id(); b.st = st;
    if (threadIdx.x == 0) (void)xb_add(&bar[XB_XCNT(b.x)], 1u);
    return b;
}
__device__ __forceinline__ void xcd_barrier_complete(unsigned* bar, unsigned x, unsigned& nloc, unsigned& nx) {
    const unsigned G = gridDim.x * gridDim.y * gridDim.z;
    unsigned sum, cnt, mine, sp = 0u;
    for (;;) {
        sum = 0u; cnt = 0u; mine = 0u;
#pragma unroll
        for (unsigned j = 0; j < 16; ++j) { const unsigned c = xb_ld(&bar[XB_XCNT(j)]); sum += c; cnt += (c > 0u) ? 1u : 0u; mine = (j == x) ? c : mine; }
        if (sum == G) break;
        __builtin_amdgcn_s_sleep(1);
        if ((++sp & 255u) == 0u) { if (xb_ld(&bar[XB_TMO])) break; if (sp > XB_SPIN_CAP) { atomicAdd(&bar[XB_TMO], 1u); break; } }
    }
    nloc = mine > 0u ? mine : 1u; nx = cnt > 0u ? cnt : 1u;
}

__device__ __forceinline__ void xcd_barrier(const XcdBarrier& b) {
    asm volatile("s_waitcnt vmcnt(0)" ::: "memory");
    __syncthreads();
    if (threadIdx.x == 0) {
        unsigned* bar = b.bar;
        __builtin_amdgcn_s_waitcnt(0);
        unsigned nloc = b.st[0], nx = b.st[1];
        if (nloc == 0u) { xcd_barrier_complete(bar, b.x, nloc, nx); b.st[0] = nloc; b.st[1] = nx; }
        const unsigned old = xb_add(&bar[XB_XSUB(b.x)], 1u);
        const unsigned gen = old / nloc;
        if (old + 1u == (gen + 1u) * nloc) {
            __builtin_amdgcn_fence(__ATOMIC_RELEASE, "agent");
            asm volatile("s_waitcnt vmcnt(0)" ::: "memory");
            const unsigned og = xb_add(&bar[XB_TOP], 1u);
            const unsigned tg = og / nx;
            if (og + 1u == (tg + 1u) * nx) xb_add(&bar[XB_TOPGEN], 1u);
            else XB_SPIN(xb_ld(&bar[XB_TOPGEN]) == tg, bar);
            __builtin_amdgcn_fence(__ATOMIC_ACQUIRE, "agent");
            xb_add(&bar[XB_XGEN(b.x)], 1u);
            asm volatile("s_waitcnt vmcnt(0)" ::: "memory");
        } else {
            XB_SPIN(xb_ld(&bar[XB_XGEN(b.x)]) == gen, bar);
            __builtin_amdgcn_fence(__ATOMIC_ACQUIRE, "agent");
            asm volatile("s_waitcnt vmcnt(0)" ::: "memory");
        }
    }
    __syncthreads();
}


DEV void xpose_job(char* lds, const float* __restrict__ src, int K, int N, bf16_t* __restrict__ dst, int mode, int& rot) {
  float* tile = (float*)lds;
  const int nk = K >> 6, nn = (N + 255) >> 8, nt = nk * nn, tid = tidx();
  const int kr = tid >> 6, nl = tid & 63;
  int t0 = (int)blockIdx.x - rot; if (t0 < 0) t0 += gridDim.x;
  rot = (rot + nt) % (int)gridDim.x;
  for (int t = t0; t < nt; t += gridDim.x) {
    const int tk = t / nn, tn = t - tk * nn, k0 = tk * 64, n0 = tn * 256;
    float v[32];
#pragma unroll
    for (int c = 0; c < 4; ++c)
#pragma unroll
      for (int i = 0; i < 8; ++i) { const int gn = n0 + c * 64 + nl; v[c * 8 + i] = gn < N ? src[(size_t)(k0 + kr + 8 * i) * N + gn] : 0.f; }
    __syncthreads();
#pragma unroll
    for (int c = 0; c < 4; ++c)
#pragma unroll
      for (int i = 0; i < 8; ++i) tile[(kr + 8 * i) * 257 + c * 64 + nl] = v[c * 8 + i];
    __syncthreads();
#pragma unroll
    for (int j = 0; j < 16; ++j) {
      const int n = (tid >> 5) + 16 * j, kk = (tid & 31) * 2, gn = n0 + n;
      if (gn < N) { const int dn = mode == 0 ? gn : ((gn >> 5) * 64 + (gn & 31) + (mode == 2 ? 32 : 0));
        *(unsigned*)(dst + (size_t)dn * K + k0 + kk) = cvtpk(tile[kk * 257 + n], tile[(kk + 1) * 257 + n]); }
    }
  }
  __syncthreads();
}

DEV void rms_rows_bf16(const float* __restrict__ src, const float* __restrict__ gain, bf16_t* __restrict__ dst) {
  const int wid = tidx() >> 6, lane = tidx() & 63;
  f32x4 g[4];
#pragma unroll
  for (int i = 0; i < 4; ++i) g[i] = *(const f32x4*)(gain + lane * 4 + 256 * i);
  for (int row = blockIdx.x * 8 + wid; row < T_TOK; row += gridDim.x * 8) {
    const float* s = src + (size_t)row * DM; f32x4 v[4]; float ss = 0.f;
#pragma unroll
    for (int i = 0; i < 4; ++i) { v[i] = __builtin_nontemporal_load((const f32x4*)(s + lane * 4 + 256 * i)); ss += v[i][0] * v[i][0] + v[i][1] * v[i][1] + v[i][2] * v[i][2] + v[i][3] * v[i][3]; }
#pragma unroll
    for (int o = 32; o >= 1; o >>= 1) ss += shfl_xor_f(ss, o);
    const float r = rsqrtf(ss * (1.f / DM) + EPS);
#pragma unroll
    for (int i = 0; i < 4; ++i) { u32x2 w; w.x = cvtpk(v[i][0] * r * g[i][0], v[i][1] * r * g[i][1]); w.y = cvtpk(v[i][2] * r * g[i][2], v[i][3] * r * g[i][3]);
      *(u32x2*)(dst + (size_t)row * DM + lane * 4 + 256 * i) = w; }
  }
}
DEV void rms_rows_f32(float* __restrict__ buf, const float* __restrict__ gain) {
  const int wid = tidx() >> 6, lane = tidx() & 63;
  f32x4 g[4];
#pragma unroll
  for (int i = 0; i < 4; ++i) g[i] = *(const f32x4*)(gain + lane * 4 + 256 * i);
  for (int row = blockIdx.x * 8 + wid; row < T_TOK; row += gridDim.x * 8) {
    float* s = buf + (size_t)row * DM; f32x4 v[4]; float ss = 0.f;
#pragma unroll
    for (int i = 0; i < 4; ++i) { v[i] = *(const f32x4*)(s + lane * 4 + 256 * i); ss += v[i][0] * v[i][0] + v[i][1] * v[i][1] + v[i][2] * v[i][2] + v[i][3] * v[i][3]; }
#pragma unroll
    for (int o = 32; o >= 1; o >>= 1) ss += shfl_xor_f(ss, o);
    const float r = rsqrtf(ss * (1.f / DM) + EPS);
#pragma unroll
    for (int i = 0; i < 4; ++i) { f32x4 w = v[i] * r * g[i]; *(f32x4*)(s + lane * 4 + 256 * i) = w; }
  }
}
DEV void cnorm_rows(const bf16_t* __restrict__ z, const float* __restrict__ qg, const float* __restrict__ kg, bf16_t* __restrict__ cn) {
  const int wid = tidx() >> 6, lane = tidx() & 63;
  for (int row = blockIdx.x * 8 + wid; row < T_TOK; row += gridDim.x * 8) {
    const bf16_t* zr = z + (size_t)row * ZLD; float a[6], c[4]; float sa = 0.f, sc = 0.f;
#pragma unroll
    for (int i = 0; i < 6; ++i) { a[i] = bf2f(zr[2560 + lane + 64 * i]); sa += a[i] * a[i]; }
#pragma unroll
    for (int i = 0; i < 4; ++i) { c[i] = bf2f(zr[2944 + lane + 64 * i]); sc += c[i] * c[i]; }
#pragma unroll
    for (int o = 32; o >= 1; o >>= 1) { sa += shfl_xor_f(sa, o); sc += shfl_xor_f(sc, o); }
    const float ra = rsqrtf(sa * (1.f / 384.f) + EPS), rc = rsqrtf(sc * (1.f / 256.f) + EPS);
    bf16_t* o = cn + (size_t)row * 640;
#pragma unroll
    for (int i = 0; i < 6; ++i) o[lane + 64 * i] = f2bf(a[i] * ra * qg[lane + 64 * i]);
#pragma unroll
    for (int i = 0; i < 4; ++i) o[384 + lane + 64 * i] = f2bf(c[i] * rc * kg[lane + 64 * i]);
  }
}

constexpr int G_TILEB = 256 * 128, G_STAGEB = 2 * G_TILEB;

struct EpiStore {
  bf16_t* C; int ldc; int mode; const float* cs; const float* sn; int perm;
  DEV void operator()(f32x4 (&acc)[8][4], int row0, int col0, int fr, int fq) const {
    const int g = col0 >> 6; const bool rope = mode == 1 ? (g == 50) : mode == 2 ? (g % 3 == 2) : mode == 3 ? (g < 32) : false;
#pragma unroll
    for (int m = 0; m < 8; ++m) {
      const int row = row0 + m * 16 + fr;
      if (mode == 2) {
#pragma unroll
        for (int n = 0; n < 4; ++n) acc[m][n] = acc[m][n] * 0.10411754627697264f; }
      if (mode == 3 && col0 < 1024) {
#pragma unroll
        for (int n = 0; n < 4; ++n) acc[m][n] = acc[m][n] * 0.18033688011112042f; }
      if (rope) { const int pos = row & (SEQ - 1);
#pragma unroll
        for (int n = 0; n < 2; ++n) { const int j0 = perm ? 8 * fq + 4 * n : n * 16 + 4 * fq;
          const f32x4 c = *(const f32x4*)(cs + pos * 32 + j0), s = *(const f32x4*)(sn + pos * 32 + j0);
          const f32x4 x1 = acc[m][n], x2 = acc[m][n + 2]; acc[m][n] = x1 * c - x2 * s; acc[m][n + 2] = x2 * c + x1 * s; } }
      if (perm) {
#pragma unroll
        for (int gg = 0; gg < 2; ++gg) { u32x4 w; w.x = cvtpk(acc[m][2 * gg][0], acc[m][2 * gg][1]); w.y = cvtpk(acc[m][2 * gg][2], acc[m][2 * gg][3]);
          w.z = cvtpk(acc[m][2 * gg + 1][0], acc[m][2 * gg + 1][1]); w.w = cvtpk(acc[m][2 * gg + 1][2], acc[m][2 * gg + 1][3]);
          *(u32x4*)(C + (size_t)row * ldc + col0 + 32 * gg + 8 * fq) = w; }
      } else {
#pragma unroll
        for (int n = 0; n < 4; ++n) { u32x2 w; w.x = cvtpk(acc[m][n][0], acc[m][n][1]); w.y = cvtpk(acc[m][n][2], acc[m][n][3]);
          *(u32x2*)(C + (size_t)row * ldc + col0 + n * 16 + 4 * fq) = w; }
      }
    }
  }
};
struct EpiResid {
  const float* res; float* out;
  DEV void operator()(f32x4 (&acc)[8][4], int row0, int col0, int fr, int fq) const {
#pragma unroll
    for (int m = 0; m < 8; ++m) { const size_t ro = (size_t)(row0 + m * 16 + fr) * DM + col0 + 4 * fq;
#pragma unroll
      for (int n = 0; n < 4; ++n) { const f32x4 r = *(const f32x4*)(res + ro + n * 16); *(f32x4*)(out + ro + n * 16) = r + acc[m][n]; }
      if ((m & 3) == 3) asm volatile("" ::: "memory"); }
  }
};
struct EpiSwiglu {
  bf16_t* H;
  DEV void operator()(f32x4 (&acc)[8][4], int row0, int col0, int fr, int fq) const {
#pragma unroll
    for (int m = 0; m < 8; ++m) { bf16_t* hp = H + (size_t)(row0 + m * 16 + fr) * FH + (col0 >> 1) + 8 * fq;
      const f32x4 g0 = acc[m][0], u0 = acc[m][2], g1 = acc[m][1], u1 = acc[m][3]; u32x4 w;
      w.x = cvtpk(siluf_(g0[0]) * u0[0], siluf_(g0[1]) * u0[1]); w.y = cvtpk(siluf_(g0[2]) * u0[2], siluf_(g0[3]) * u0[3]);
      w.z = cvtpk(siluf_(g1[0]) * u1[0], siluf_(g1[1]) * u1[1]); w.w = cvtpk(siluf_(g1[2]) * u1[2], siluf_(g1[3]) * u1[3]);
      *(u32x4*)hp = w; }
  }
};

template <class Epi, bool PERM = false>
DEV void gemm_phase(char* lds, const bf16_t* __restrict__ A, int lda, const bf16_t* __restrict__ Bt, int ldb, int K, int nN, int nTiles, const Epi& E) {
  const int tid = tidx(), wid = tid >> 6, lane = tid & 63, wr = wid >> 2, wc = wid & 3, fr = lane & 15, fq = lane >> 4;
  const int nk = K >> 6, lrow = tid >> 3, lkc = tid & 7;
  const int hw = (((lrow >> 1) & 1) << 1) | (((lrow >> 3) & 1) << 2), hr = (((fr >> 1) & 1) << 1) | (((fr >> 3) & 1) << 2);
  const unsigned wofs = lrow * 128 + ((lkc ^ hw) << 4);
  const unsigned aofs0 = (wr * 128 + fr) * 128 + ((fq ^ hr) << 4), aofs1 = (wr * 128 + fr) * 128 + (((4 + fq) ^ hr) << 4);
  const unsigned bofs0 = G_TILEB + (wc * 64 + fr) * 128 + ((fq ^ hr) << 4), bofs1 = G_TILEB + (wc * 64 + fr) * 128 + (((4 + fq) ^ hr) << 4);
  const unsigned ao = (unsigned)(lrow * lda + lkc * 8) * 2u, bo = (unsigned)(lrow * ldb + lkc * 8) * 2u;
  const unsigned as64 = (unsigned)(64 * lda) * 2u, bs64 = (unsigned)(64 * ldb) * 2u;
  typedef __attribute__((address_space(3))) unsigned lds_u32;
  const int lrb = PERM ? ((lrow & ~31) + 8 * ((lrow & 15) >> 2) + 4 * ((lrow >> 4) & 1) + (lrow & 3)) : lrow;
  const unsigned gao = (unsigned)(lrow * lda + ((lkc ^ hw) << 3)) * 2u, gbo = (unsigned)(lrb * ldb + ((lkc ^ hw) << 3)) * 2u;
  const unsigned ldsw = (unsigned)wid * 1024u;
#define G_DMA(AB, BB, stg, k0) do { _Pragma("unroll") for (int i = 0; i < 4; ++i) { \
      __builtin_amdgcn_global_load_lds((const unsigned*)((AB) + (k0) * 2 + gao + i * as64), (lds_u32*)(lds + (stg) * G_STAGEB + ldsw + i * 8192), 16, 0, 0); \
      __builtin_amdgcn_global_load_lds((const unsigned*)((BB) + (k0) * 2 + gbo + i * bs64), (lds_u32*)(lds + (stg) * G_STAGEB + G_TILEB + ldsw + i * 8192), 16, 0, 0); } } while (0)
#define G_HALF(AO, BO, M0) do { _Pragma("unroll") for (int m = 0; m < 4; ++m) af[m] = *(const bf16x8*)(cur + (AO) + ((M0) + m) * 2048); \
      _Pragma("unroll") for (int m = 0; m < 4; ++m) _Pragma("unroll") for (int n = 0; n < 4; ++n) acc[(M0) + m][n] = __builtin_amdgcn_mfma_f32_16x16x32_bf16(bfr[n], af[m], acc[(M0) + m][n], 0, 0, 0); } while (0)
  int t = vblock();
  if (t >= nTiles) return;
  int pm = t / nN, pn = t - pm * nN;
  const char* Ab = (const char*)(A + (size_t)pm * 256 * lda);
  const char* Bb = (const char*)(Bt + (size_t)pn * 256 * ldb);
  __syncthreads();
  G_DMA(Ab, Bb, 0, 0);
  asm volatile("s_waitcnt vmcnt(0)" ::: "memory");
  __syncthreads();
  int stg = 0;
  for (;;) {
    f32x4 acc[8][4];
#pragma unroll
    for (int m = 0; m < 8; ++m)
#pragma unroll
      for (int n = 0; n < 4; ++n) acc[m][n] = (f32x4){0.f, 0.f, 0.f, 0.f};
    const int tn = t + (int)gridDim.x; const bool more = tn < nTiles;
    const int npm = more ? tn / nN : pm, npn = more ? tn - npm * nN : pn;
    const char* nAb = (const char*)(A + (size_t)npm * 256 * lda);
    const char* nBb = (const char*)(Bt + (size_t)npn * 256 * ldb);
    for (int kt = 0; kt < nk; ++kt) {
      const char* cur = lds + stg * G_STAGEB;
      if (kt + 1 < nk) G_DMA(Ab, Bb, stg ^ 1, (kt + 1) * 64);
      else if (more) G_DMA(nAb, nBb, stg ^ 1, 0);
      bf16x8 bfr[4], af[4];
#pragma unroll
      for (int n = 0; n < 4; ++n) bfr[n] = *(const bf16x8*)(cur + bofs0 + n * 2048);
#pragma unroll
      for (int m = 0; m < 4; ++m) af[m] = *(const bf16x8*)(cur + aofs0 + m * 2048);
#pragma unroll
      for (int m = 0; m < 4; ++m)
#pragma unroll
        for (int n = 0; n < 4; ++n) acc[m][n] = __builtin_amdgcn_mfma_f32_16x16x32_bf16(bfr[n], af[m], acc[m][n], 0, 0, 0);
      G_HALF(aofs0, bofs0, 4);
#pragma unroll
      for (int n = 0; n < 4; ++n) bfr[n] = *(const bf16x8*)(cur + bofs1 + n * 2048);
      G_HALF(aofs1, bofs1, 0);
      G_HALF(aofs1, bofs1, 4);
      asm volatile("s_waitcnt vmcnt(0)" ::: "memory");
      __syncthreads();
      stg ^= 1;
    }
    E(acc, pm * 256 + wr * 128, pn * 256 + wc * 64, fr, fq);
    if (!more) break;
    t = tn; pm = npm; pn = npn; Ab = nAb; Bb = nBb;
  }
#undef G_DMA
#undef G_HALF
}

#define SBAR() __builtin_amdgcn_sched_barrier(0)
DEV int crow(int r, int hi) { return (r & 3) + 8 * (r >> 2) + 4 * hi; }
constexpr float ATT_THR = 8.f;
template <int NQK> struct AttnK {
  static constexpr int DQK = NQK * 16, KROWB = DQK * 2, SHM_K = 64 * KROWB, SHM_V = 64 * 128 * 2, SHM = 2 * SHM_V + 2 * SHM_K + 8 * 64 * 4;
  static constexpr float SCALE = NQK == 12 ? 0.07216878364870323f : 0.125f;
  static constexpr int TAILC = NQK == 12 ? 128 : 0;
};
template <int NQK> DEV void partialSM(f32x16& p0, f32x16& p1, float& m_reg, float& mn, float& alpha) {
  constexpr float SC = AttnK<NQK>::SCALE, C = SC * 1.4426950408889634f;
  float pmax = p0[0];
#pragma unroll
  for (int r = 1; r < 16; ++r) pmax = fmaxf(pmax, p0[r]);
#pragma unroll
  for (int r = 0; r < 16; ++r) pmax = fmaxf(pmax, p1[r]);
  { auto rr = __builtin_amdgcn_permlane32_swap(__float_as_uint(pmax), __float_as_uint(pmax), false, false);
    pmax = fmaxf(__uint_as_float(rr[0]), __uint_as_float(rr[1])); }
  if (__builtin_expect(__all(pmax - m_reg <= ATT_THR / SC), 1)) { mn = m_reg; alpha = 1.f; }
  else { mn = fmaxf(m_reg, pmax); alpha = __builtin_amdgcn_exp2f((m_reg - mn) * C); m_reg = mn; }
  const float mnC = -mn * C;
#pragma unroll
  for (int r = 0; r < 16; ++r) p0[r] = fmaf(p0[r], C, mnC);
#pragma unroll
  for (int r = 0; r < 16; ++r) p1[r] = fmaf(p1[r], C, mnC);
#pragma unroll
  for (int r = 0; r < 16; ++r) p0[r] = __builtin_amdgcn_exp2f(p0[r]);
}
DEV void finishSM(f32x16& p0, f32x16& p1, float alpha, float& l_reg, bf16x8& pa0, bf16x8& pa1, bf16x8& pa2, bf16x8& pa3) {
#pragma unroll
  for (int r = 0; r < 16; ++r) p1[r] = __builtin_amdgcn_exp2f(p1[r]);
  float ps = 0;
#pragma unroll
  for (int r = 0; r < 16; ++r) ps += p0[r];
#pragma unroll
  for (int r = 0; r < 16; ++r) ps += p1[r];
  { auto rr = __builtin_amdgcn_permlane32_swap(__float_as_uint(ps), __float_as_uint(ps), false, false);
    ps = __uint_as_float(rr[0]) + __uint_as_float(rr[1]); }
  l_reg = l_reg * alpha + ps;
#define PK4(P, BASE, OUT) do { unsigned a0 = cvtpk(P[BASE + 0], P[BASE + 1]), a1 = cvtpk(P[BASE + 2], P[BASE + 3]);   \
    unsigned b0 = cvtpk(P[BASE + 4], P[BASE + 5]), b1 = cvtpk(P[BASE + 6], P[BASE + 7]);                              \
    auto r0 = __builtin_amdgcn_permlane32_swap(a0, b0, false, false); auto r1 = __builtin_amdgcn_permlane32_swap(a1, b1, false, false); \
    u32x4 w = {r0[0], r1[0], r0[1], r1[1]}; OUT = *reinterpret_cast<bf16x8*>(&w); } while (0)
  PK4(p0, 0, pa0); PK4(p0, 8, pa1); PK4(p1, 0, pa2); PK4(p1, 8, pa3);
#undef PK4
}
template <int NQK> DEV void qkt(f32x16& p0, f32x16& p1, const char* Ks, const bf16x8* qr, int r32, int hi) {
  constexpr int KROWB = AttnK<NQK>::KROWB;
  p0 = f32x16{}; p1 = f32x16{};
#pragma unroll
  for (int d0 = 0; d0 < NQK; ++d0) { const int cb = (d0 * 16 + hi * 8) * 2;
    const bf16x8 b0 = *reinterpret_cast<const bf16x8*>(Ks + r32 * KROWB + (cb ^ ((r32 & 7) << 4)));
    const bf16x8 b1 = *reinterpret_cast<const bf16x8*>(Ks + (32 + r32) * KROWB + (cb ^ ((r32 & 7) << 4)));
    p0 = __builtin_amdgcn_mfma_f32_32x32x16_bf16(b0, qr[d0], p0, 0, 0, 0);
    p1 = __builtin_amdgcn_mfma_f32_32x32x16_bf16(b1, qr[d0], p1, 0, 0, 0); }
}
DEV int v_st(int k, int c) { const int kk = (k & ~0xC) | ((k & 4) << 1) | ((k & 8) >> 1); return ((kk >> 3) * 4 + (c >> 5)) * 512 + ((kk & 7) * 32 + (c & 31)) * 2; }
DEV int v_rd_base(int lane) { return ((lane & 3) << 3) | (((lane >> 2) & 3) << 6) | (((lane >> 4) & 1) << 5) | (((lane >> 5) & 1) << 8); }
constexpr int v_rd_off(int d0, int ks, int half) { return d0 * 512 + ks * 4096 + half * 2048; }
template <int OFF> DEV s16x4 tr_read(int vb) { s16x4 r; asm volatile("ds_read_b64_tr_b16 %0, %1 offset:%2" : "=&v"(r) : "v"(vb), "i"(OFF) : "memory"); return r; }
template <int D0> DEV void pv_one(f32x16& od, int vb, bf16x8 pa0, bf16x8 pa1, bf16x8 pa2, bf16x8 pa3) {
  const s16x4 l0 = tr_read<v_rd_off(D0, 0, 0)>(vb), h0 = tr_read<v_rd_off(D0, 0, 1)>(vb), l1 = tr_read<v_rd_off(D0, 1, 0)>(vb), h1 = tr_read<v_rd_off(D0, 1, 1)>(vb);
  const s16x4 l2 = tr_read<v_rd_off(D0, 2, 0)>(vb), h2 = tr_read<v_rd_off(D0, 2, 1)>(vb), l3 = tr_read<v_rd_off(D0, 3, 0)>(vb), h3 = tr_read<v_rd_off(D0, 3, 1)>(vb);
  asm volatile("s_waitcnt lgkmcnt(0)" ::: "memory"); SBAR();
#define PKV(L, H) (bf16x8){L[0], L[1], L[2], L[3], H[0], H[1], H[2], H[3]}
  od = __builtin_amdgcn_mfma_f32_32x32x16_bf16(pa0, PKV(l0, h0), od, 0, 0, 0);
  od = __builtin_amdgcn_mfma_f32_32x32x16_bf16(pa1, PKV(l1, h1), od, 0, 0, 0);
  od = __builtin_amdgcn_mfma_f32_32x32x16_bf16(pa2, PKV(l2, h2), od, 0, 0, 0);
  od = __builtin_amdgcn_mfma_f32_32x32x16_bf16(pa3, PKV(l3, h3), od, 0, 0, 0);
#undef PKV
}
DEV void pv_d0(f32x16* o, int vb, bf16x8 pa0, bf16x8 pa1, bf16x8 pa2, bf16x8 pa3) {
  pv_one<0>(o[0], vb, pa0, pa1, pa2, pa3); pv_one<1>(o[1], vb, pa0, pa1, pa2, pa3); pv_one<2>(o[2], vb, pa0, pa1, pa2, pa3); pv_one<3>(o[3], vb, pa0, pa1, pa2, pa3);
}

template <int NQK> DEV void qkt_pre(f32x16& p0, f32x16& p1, const char* Ks, const bf16x8* qr, int r32, int hi, float m_reg) {
  constexpr int KROWB = AttnK<NQK>::KROWB;
  f32x16 nm;
#pragma unroll
  for (int r = 0; r < 16; ++r) nm[r] = -m_reg;
#pragma unroll
  for (int d0 = 0; d0 < NQK; ++d0) { const int cb = (d0 * 16 + hi * 8) * 2;
    const bf16x8 b0 = *reinterpret_cast<const bf16x8*>(Ks + r32 * KROWB + (cb ^ ((r32 & 7) << 4)));
    const bf16x8 b1 = *reinterpret_cast<const bf16x8*>(Ks + (32 + r32) * KROWB + (cb ^ ((r32 & 7) << 4)));
    p0 = __builtin_amdgcn_mfma_f32_32x32x16_bf16(b0, qr[d0], d0 == 0 ? nm : p0, 0, 0, 0);
    p1 = __builtin_amdgcn_mfma_f32_32x32x16_bf16(b1, qr[d0], d0 == 0 ? nm : p1, 0, 0, 0); }
}
DEV void partialSM_pre(f32x16& p0, f32x16& p1, float& m_reg, float& alpha, bool first) {
  constexpr float THRL = ATT_THR * 1.4426950408889634f;
  float pmax = p0[0];
#pragma unroll
  for (int r = 1; r < 16; ++r) pmax = fmaxf(pmax, p0[r]);
#pragma unroll
  for (int r = 0; r < 16; ++r) pmax = fmaxf(pmax, p1[r]);
  { auto rr = __builtin_amdgcn_permlane32_swap(__float_as_uint(pmax), __float_as_uint(pmax), false, false);
    pmax = fmaxf(__uint_as_float(rr[0]), __uint_as_float(rr[1])); }
  if (__builtin_expect(!first && __all(pmax <= THRL), 1)) { alpha = 1.f; }
  else { const float delta = first ? pmax : fmaxf(pmax, 0.f); alpha = first ? 1.f : __builtin_amdgcn_exp2f(-delta); m_reg += delta;
#pragma unroll
    for (int r = 0; r < 16; ++r) p0[r] -= delta;
#pragma unroll
    for (int r = 0; r < 16; ++r) p1[r] -= delta; }
#pragma unroll
  for (int r = 0; r < 16; ++r) p0[r] = __builtin_amdgcn_exp2f(p0[r]);
}
template <int NQK, bool PRE = false>
DEV void attn_body(const bf16_t* __restrict__ Qb, int ldq, const bf16_t* __restrict__ Kn, int ldkn, const bf16_t* __restrict__ Kt, int ldkt,
                   const bf16_t* __restrict__ Vh, int ldv, int seq, char* lds, f32x16 (&o)[4]) {
  typedef AttnK<NQK> CF;
  constexpr int SHM_V = CF::SHM_V, SHM_K = CF::SHM_K, KROWB = CF::KROWB, TAILC = CF::TAILC;
  const int tid = tidx(), wid = tid >> 6, lane = tid & 63, r32 = lane & 31, hi = lane >> 5;
  char* V_lds = lds; char* K_lds = lds + 2 * SHM_V;
  float* wsl = (float*)(lds + 2 * SHM_V + 2 * SHM_K) + wid * 64; float* li_l = wsl; float* al_l = wsl + 32;
  float m_reg = PRE ? 0.f : -1e30f, l_reg = 0;
#pragma unroll
  for (int d = 0; d < 4; ++d) o[d] = f32x16{};
  bf16x8 qr[NQK];
  const bf16_t* Qw = Qb + (size_t)(wid * 32 + r32) * ldq + hi * 8;
#pragma unroll
  for (int d0 = 0; d0 < NQK; ++d0) qr[d0] = *(const bf16x8*)(Qw + d0 * 16);
  const int sr = tid >> 4, sc = (tid & 15) * 8, vst0 = v_st(sr, sc), vst1 = v_st(32 + sr, sc);
  const int tr = tid >> 3, tc = (tid & 7) * 8;
  const int kst0 = sr * KROWB + ((sc * 2) ^ ((sr & 7) << 4)), kst1 = (32 + sr) * KROWB + ((sc * 2) ^ ((sr & 7) << 4));
  const int kstt = tr * KROWB + (((TAILC + tc) * 2) ^ ((tr & 7) << 4));
  const int vb0 = (int)(uintptr_t)V_lds + v_rd_base(lane);
  bf16x8 sv0[2], sv1[2], sk0[2], sk1[2], skt[2];
#define SLOAD(i, k0) do { sv0[i] = *(const bf16x8*)(Vh + (size_t)((k0) + sr) * ldv + sc); sv1[i] = *(const bf16x8*)(Vh + (size_t)((k0) + 32 + sr) * ldv + sc); \
    if (NQK == 12) { sk0[i] = *(const bf16x8*)(Kn + (size_t)((k0) + sr) * ldkn + sc); sk1[i] = *(const bf16x8*)(Kn + (size_t)((k0) + 32 + sr) * ldkn + sc); } \
    skt[i] = *(const bf16x8*)(Kt + (size_t)((k0) + tr) * ldkt + tc); } while (0)
#define SWRITE(b, i) do { *(bf16x8*)(V_lds + (b) * SHM_V + vst0) = sv0[i]; *(bf16x8*)(V_lds + (b) * SHM_V + vst1) = sv1[i]; \
    if (NQK == 12) { *(bf16x8*)(K_lds + (b) * SHM_K + kst0) = sk0[i]; *(bf16x8*)(K_lds + (b) * SHM_K + kst1) = sk1[i]; } \
    *(bf16x8*)(K_lds + (b) * SHM_K + kstt) = skt[i]; } while (0)
#define SWAIT() do { if (NQK == 12) asm volatile("s_waitcnt vmcnt(5)" ::: "memory"); else asm volatile("s_waitcnt vmcnt(3)" ::: "memory"); } while (0)
#define RESC(a) do { if (__any((a) < 1.f)) { if (hi == 0) al_l[r32] = (a); asm volatile("s_waitcnt lgkmcnt(0)" ::: "memory"); \
    _Pragma("unroll") for (int d = 0; d < 4; ++d) _Pragma("unroll") for (int r = 0; r < 16; ++r) o[d][r] *= al_l[crow(r, hi)]; } } while (0)
#define QKT(P0, P1, KS) do { if (PRE) qkt_pre<NQK>(P0, P1, KS, qr, r32, hi, m_reg); else qkt<NQK>(P0, P1, KS, qr, r32, hi); } while (0)
#define PSM(P0, P1, MN, AL, FIRST) do { if (PRE) partialSM_pre(P0, P1, m_reg, AL, FIRST); else partialSM<NQK>(P0, P1, m_reg, MN, AL); } while (0)
  f32x16 pA0, pA1, pB0, pB1; float mnA = 0.f, mnB = 0.f, alA, alB; bf16x8 pa0, pa1, pa2, pa3; const int NT = seq / 64;
  __syncthreads();
  SLOAD(0, 0); asm volatile("s_waitcnt vmcnt(0)" ::: "memory"); SWRITE(0, 0); __syncthreads();
  QKT(pA0, pA1, K_lds); PSM(pA0, pA1, mnA, alA, true);
  SLOAD(1, 64); if (2 < NT) SLOAD(0, 128);
  SWAIT(); SWRITE(1, 1); __syncthreads();
  for (int j = 1; j + 1 < NT; j += 2) {
    SBAR(); QKT(pB0, pB1, K_lds + SHM_K);
    finishSM(pA0, pA1, alA, l_reg, pa0, pa1, pa2, pa3); SBAR();
    SLOAD(1, (j + 2) * 64); SBAR();
    pv_d0(o, vb0, pa0, pa1, pa2, pa3); PSM(pB0, pB1, mnB, alB, false);
    __syncthreads(); SWAIT(); SWRITE(0, 0);
    RESC(alB); __syncthreads();
    SBAR(); QKT(pA0, pA1, K_lds);
    finishSM(pB0, pB1, alB, l_reg, pa0, pa1, pa2, pa3); SBAR();
    if (j + 3 < NT) SLOAD(0, (j + 3) * 64); SBAR();
    pv_d0(o, vb0 + SHM_V, pa0, pa1, pa2, pa3); PSM(pA0, pA1, mnA, alA, false);
    __syncthreads(); SWAIT(); SWRITE(1, 1);
    RESC(alA); __syncthreads();
  }
  SBAR(); QKT(pB0, pB1, K_lds + SHM_K);
  finishSM(pA0, pA1, alA, l_reg, pa0, pa1, pa2, pa3); SBAR();
  pv_d0(o, vb0, pa0, pa1, pa2, pa3); PSM(pB0, pB1, mnB, alB, false);
  __syncthreads(); RESC(alB);
  finishSM(pB0, pB1, alB, l_reg, pa0, pa1, pa2, pa3); SBAR();
  pv_d0(o, vb0 + SHM_V, pa0, pa1, pa2, pa3);
  if (hi == 0) li_l[r32] = l_reg; asm volatile("s_waitcnt lgkmcnt(0)" ::: "memory");
#pragma unroll
  for (int r = 0; r < 16; ++r) { const float rl = __builtin_amdgcn_rcpf(li_l[crow(r, hi)]);
#pragma unroll
    for (int d = 0; d < 4; ++d) o[d][r] *= rl; }
#undef SLOAD
#undef SWRITE
#undef SWAIT
#undef RESC
#undef QKT
#undef PSM
}

template <int NQK, bool PRE = false>
DEV void attn_body_s(const bf16_t* __restrict__ Qb, int ldq, const bf16_t* __restrict__ Kn, int ldkn, const bf16_t* __restrict__ Kt, int ldkt,
                     const bf16_t* __restrict__ Vh, int ldv, int seq, char* lds, f32x16 (&o)[4]) {
  typedef AttnK<NQK> CF;
  constexpr int SHM_V = CF::SHM_V, SHM_K = CF::SHM_K, KROWB = CF::KROWB, TAILC = CF::TAILC;
  const int tid = tidx(), wid = tid >> 6, lane = tid & 63, r32 = lane & 31, hi = lane >> 5;
  char* V_lds = lds; char* K_lds = lds + 2 * SHM_V;
  float* wsl = (float*)(lds + 2 * SHM_V + 2 * SHM_K) + wid * 64; float* li_l = wsl; float* al_l = wsl + 32;
  float m_reg = PRE ? 0.f : -1e30f, l_reg = 0;
#pragma unroll
  for (int d = 0; d < 4; ++d) o[d] = f32x16{};
  bf16x8 qr[NQK];
  const bf16_t* Qw = Qb + (size_t)(wid * 32 + r32) * ldq + hi * 8;
#pragma unroll
  for (int d0 = 0; d0 < NQK; ++d0) qr[d0] = *(const bf16x8*)(Qw + d0 * 16);
  const int sr = tid >> 4, sc = (tid & 15) * 8, vst0 = v_st(sr, sc), vst1 = v_st(32 + sr, sc);
  const int tr = tid >> 3, tc = (tid & 7) * 8;
  const int kst0 = sr * KROWB + ((sc * 2) ^ ((sr & 7) << 4)), kst1 = (32 + sr) * KROWB + ((sc * 2) ^ ((sr & 7) << 4));
  const int kstt = tr * KROWB + (((TAILC + tc) * 2) ^ ((tr & 7) << 4));
  const int vb0 = (int)(uintptr_t)V_lds + v_rd_base(lane);
  bf16x8 sv0, sv1, sk0, sk1, skt;
#define SLOAD1(k0) do { sv0 = *(const bf16x8*)(Vh + (size_t)((k0) + sr) * ldv + sc); sv1 = *(const bf16x8*)(Vh + (size_t)((k0) + 32 + sr) * ldv + sc); \
    if (NQK == 12) { sk0 = *(const bf16x8*)(Kn + (size_t)((k0) + sr) * ldkn + sc); sk1 = *(const bf16x8*)(Kn + (size_t)((k0) + 32 + sr) * ldkn + sc); } \
    skt = *(const bf16x8*)(Kt + (size_t)((k0) + tr) * ldkt + tc); } while (0)
#define SWRITE1(b) do { *(bf16x8*)(V_lds + (b) * SHM_V + vst0) = sv0; *(bf16x8*)(V_lds + (b) * SHM_V + vst1) = sv1; \
    if (NQK == 12) { *(bf16x8*)(K_lds + (b) * SHM_K + kst0) = sk0; *(bf16x8*)(K_lds + (b) * SHM_K + kst1) = sk1; } \
    *(bf16x8*)(K_lds + (b) * SHM_K + kstt) = skt; } while (0)
  f32x16 p0, p1; float mn, al; bf16x8 pa0, pa1, pa2, pa3; const int NT = seq / 64;
  __syncthreads();
  SLOAD1(0); SWRITE1(0); SLOAD1(64);
  __syncthreads();
  for (int j = 0; j < NT; ++j) {
    const int b = j & 1;
    if (j + 1 < NT) { SWRITE1(b ^ 1); if (j + 2 < NT) SLOAD1((j + 2) * 64); }
    if (PRE) { qkt_pre<NQK>(p0, p1, K_lds + b * SHM_K, qr, r32, hi, m_reg); partialSM_pre(p0, p1, m_reg, al, j == 0); }
    else { qkt<NQK>(p0, p1, K_lds + b * SHM_K, qr, r32, hi); partialSM<NQK>(p0, p1, m_reg, mn, al); }
    if (__any(al < 1.f)) { if (hi == 0) al_l[r32] = al; asm volatile("s_waitcnt lgkmcnt(0)" ::: "memory");
#pragma unroll
      for (int d = 0; d < 4; ++d)
#pragma unroll
        for (int r = 0; r < 16; ++r) o[d][r] *= al_l[crow(r, hi)]; }
    finishSM(p0, p1, al, l_reg, pa0, pa1, pa2, pa3);
    pv_d0(o, vb0 + b * SHM_V, pa0, pa1, pa2, pa3);
    __syncthreads();
  }
  if (hi == 0) li_l[r32] = l_reg; asm volatile("s_waitcnt lgkmcnt(0)" ::: "memory");
#pragma unroll
  for (int r = 0; r < 16; ++r) { const float rl = __builtin_amdgcn_rcpf(li_l[crow(r, hi)]);
#pragma unroll
    for (int d = 0; d < 4; ++d) o[d][r] *= rl; }
#undef SLOAD1
#undef SWRITE1
}

constexpr int H_RS = 272;
constexpr int H_TS = 144;
DEV void hgrn_prep(const bf16_t* __restrict__ z, const float* __restrict__ hg_lb, int tok0, int hh, int dir, int k, int qq, float* tot,
                   float (&cum)[16], float (&kk)[16], float& total, float& ref, const bf16_t (&fraw)[16]) {
  const int ch = hh * 128 + k;
  const float a0 = hg_lb[dir * 1024 + ch], a1 = hg_lb[dir * 1024 + 512 + ch];
  const float lb = 1.f / (1.f + __expf(a1 - a0));
#pragma unroll
  for (int i = 0; i < 16; ++i) { const float fp = bf2f(fraw[i]); const float sg = sigmoidf_(fp);
    cum[i] = __logf(lb + (1.f - lb) * sg); kk[i] = (1.f - lb) * (1.f - sg); }
  if (dir == 0) {
#pragma unroll
    for (int i = 1; i < 16; ++i) cum[i] += cum[i - 1];
    tot[qq * 128 + k] = cum[15];
  } else {
#pragma unroll
    for (int i = 14; i >= 0; --i) cum[i] += cum[i + 1];
    tot[qq * 128 + k] = cum[0];
  }
  __syncthreads();
  const float t0 = tot[k], t1 = tot[128 + k], t2 = tot[256 + k], t3 = tot[384 + k];
  total = (t0 + t1) + (t2 + t3);
  float offs;
  if (dir == 0) { offs = (qq > 0 ? t0 : 0.f) + (qq > 1 ? t1 : 0.f) + (qq > 2 ? t2 : 0.f); ref = t0 + t1; }
  else { offs = (qq < 3 ? t3 : 0.f) + (qq < 2 ? t2 : 0.f) + (qq < 1 ? t1 : 0.f); ref = t2 + t3; }
#pragma unroll
  for (int i = 0; i < 16; ++i) cum[i] += offs;
}
DEV void hgrn_load16(const bf16_t* __restrict__ p, bf16_t (&r)[16]) {
#pragma unroll
  for (int i = 0; i < 16; ++i) r[i] = p[(size_t)i * ZLD];
}
DEV void pack16_store(char* dst, const float (&v)[16]) {
  u32x4 w0, w1;
  w0.x = cvtpk(v[0], v[1]); w0.y = cvtpk(v[2], v[3]); w0.z = cvtpk(v[4], v[5]); w0.w = cvtpk(v[6], v[7]);
  w1.x = cvtpk(v[8], v[9]); w1.y = cvtpk(v[10], v[11]); w1.z = cvtpk(v[12], v[13]); w1.w = cvtpk(v[14], v[15]);
  *(u32x4*)dst = w0; *(u32x4*)(dst + 16) = w1;
}
DEV void hgrn_stepA(char* lds, const bf16_t* __restrict__ z, const float* __restrict__ hg_lb, bf16_t* __restrict__ ST, float* __restrict__ HD) {
  const int tid = tidx(), wid = tid >> 6, lane = tid & 63, fr = lane & 15, fq = lane >> 4, k = tid & 127, qq = tid >> 7;
  char* KdT = lds;
  char* VT = lds + 128 * H_TS;
  float* tot = (float*)(lds + 2 * 128 * H_TS);
  bf16_t pf[16], pv[16];
#define HA_LOAD(U) do { const int j_ = (U) & 127, r_ = (U) >> 7, d_ = r_ & 1, h_ = (r_ >> 1) & 3, b_ = r_ >> 3; \
    const bf16_t* zb_ = z + (size_t)(b_ * SEQ + j_ * 64 + qq * 16) * ZLD + h_ * 128 + k; hgrn_load16(zb_ + 512 + d_ * 512, pf); hgrn_load16(zb_ + 1536, pv); } while (0)
  { const int u0 = vblock(); if (u0 < 4096) HA_LOAD(u0); }
  for (int u = vblock(); u < 4096; u += gridDim.x) {
    const int j = u & 127, rest = u >> 7, dir = rest & 1, hh = (rest >> 1) & 3, b = rest >> 3;
    const int tok0 = b * SEQ + j * 64;
    float cum[16], kk[16], total, ref;
    bf16_t cf[16], cv[16];
#pragma unroll
    for (int i = 0; i < 16; ++i) { cf[i] = pf[i]; cv[i] = pv[i]; }
    if (u + (int)gridDim.x < 4096) HA_LOAD(u + (int)gridDim.x);
    __syncthreads();
    hgrn_prep(z, hg_lb, tok0, hh, dir, k, qq, tot, cum, kk, total, ref, cf);
    float kd[16], vv[16];
#pragma unroll
    for (int i = 0; i < 16; ++i) { kd[i] = kk[i] * __expf(total - cum[i]); vv[i] = bf2f(cv[i]); }
    pack16_store(KdT + k * H_TS + qq * 32, kd);
    pack16_store(VT + k * H_TS + qq * 32, vv);
    if (qq == 0) HD[(size_t)u * 128 + k] = __expf(total);
    __syncthreads();
    f32x4 acc[8];
#pragma unroll
    for (int m = 0; m < 8; ++m) acc[m] = (f32x4){0.f, 0.f, 0.f, 0.f};
#pragma unroll
    for (int ks = 0; ks < 2; ++ks) { const bf16x8 bv = *(const bf16x8*)(VT + (wid * 16 + fr) * H_TS + ks * 64 + fq * 16);
#pragma unroll
      for (int m = 0; m < 8; ++m) { const bf16x8 ak = *(const bf16x8*)(KdT + (m * 16 + fr) * H_TS + ks * 64 + fq * 16);
        acc[m] = __builtin_amdgcn_mfma_f32_16x16x32_bf16(ak, bv, acc[m], 0, 0, 0); } }
    bf16_t* sp = ST + (size_t)u * 16384 + (wid * 16 + fr) * 128 + 4 * fq;
#pragma unroll
    for (int m = 0; m < 8; ++m) { u32x2 w; w.x = cvtpk(acc[m][0], acc[m][1]); w.y = cvtpk(acc[m][2], acc[m][3]); *(u32x2*)(sp + m * 16) = w; }
  }
}
DEV void hgrn_stepB(bf16_t* __restrict__ ST, const float* __restrict__ HD) {
  for (int gid = blockIdx.x * NTHR + tidx(); gid < 32 * 4096; gid += gridDim.x * NTHR) {
    const int seq = gid >> 12, e = (gid & 4095) * 4, kq = e & 127, dir = seq & 1;
    float S0 = 0.f, S1 = 0.f, S2 = 0.f, S3 = 0.f;
    for (int s0 = 0; s0 < 128; s0 += 8) {
      u32x2 uu[8]; f32x4 dd[8];
#pragma unroll
      for (int i = 0; i < 8; ++i) { const int j = dir ? 127 - (s0 + i) : (s0 + i); const size_t un = (size_t)seq * 128 + j;
        uu[i] = *(const u32x2*)(ST + un * 16384 + e); dd[i] = *(const f32x4*)(HD + un * 128 + kq); }
#pragma unroll
      for (int i = 0; i < 8; ++i) { const int j = dir ? 127 - (s0 + i) : (s0 + i); const size_t un = (size_t)seq * 128 + j;
        u32x2 w; w.x = cvtpk(S0, S1); w.y = cvtpk(S2, S3); *(u32x2*)(ST + un * 16384 + e) = w;
        S0 = dd[i][0] * S0 + __uint_as_float(uu[i].x << 16); S1 = dd[i][1] * S1 + __uint_as_float(uu[i].x & 0xffff0000u);
        S2 = dd[i][2] * S2 + __uint_as_float(uu[i].y << 16); S3 = dd[i][3] * S3 + __uint_as_float(uu[i].y & 0xffff0000u); }
    }
  }
}
DEV void hgrn_stepC(char* lds, const bf16_t* __restrict__ z, const float* __restrict__ hg_lb, const float* __restrict__ hg_norm,
                    const bf16_t* __restrict__ ST, bf16_t* __restrict__ mix) {
  const int tid = tidx(), wid = tid >> 6, lane = tid & 63, fr = lane & 15, fq = lane >> 4, k = tid & 127, qq = tid >> 7;
  const int mt = wid & 3, chh = wid >> 2;
  char* Qd = lds; char* Kd = lds + 64 * H_RS; char* Qs = lds + 128 * H_RS;
  char* VT = lds + 192 * H_RS;
  char* Pm = VT + 128 * H_TS;
  float* tot = (float*)(Pm + 64 * H_TS);
  float* ssq = tot + 512;
  bf16_t pq[16], pv[16], pf0[16], pf1[16];
#define HC_LOAD(U) do { const int j_ = (U) & 127, h_ = ((U) >> 7) & 3, b_ = (U) >> 9; const bf16_t* zb_ = z + (size_t)(b_ * SEQ + j_ * 64 + qq * 16) * ZLD + h_ * 128 + k; \
    hgrn_load16(zb_, pq); hgrn_load16(zb_ + 512, pf0); hgrn_load16(zb_ + 1024, pf1); hgrn_load16(zb_ + 1536, pv); } while (0)
  { const int u0 = vblock(); if (u0 < 2048) HC_LOAD(u0); }
  for (int u = vblock(); u < 2048; u += gridDim.x) {
    const int j = u & 127, hh = (u >> 7) & 3, b = u >> 9;
    const int tok0 = b * SEQ + j * 64;
    bf16_t cq[16], cv[16], cf0[16], cf1[16];
#pragma unroll
    for (int i = 0; i < 16; ++i) { cq[i] = pq[i]; cv[i] = pv[i]; cf0[i] = pf0[i]; cf1[i] = pf1[i]; }
    if (u + (int)gridDim.x < 2048) HC_LOAD(u + (int)gridDim.x);
    f32x4 ao[4];
#pragma unroll
    for (int n = 0; n < 4; ++n) ao[n] = (f32x4){0.f, 0.f, 0.f, 0.f};
    for (int dir = 0; dir < 2; ++dir) {
      float cum[16], kk[16], total, ref;
      bf16_t cf[16];
#pragma unroll
      for (int i = 0; i < 16; ++i) cf[i] = dir ? cf1[i] : cf0[i];
      bf16x8 sfr[16];
      { const int un_ = ((b * 4 + hh) * 2 + dir) * 128 + j; const bf16_t* sp_ = ST + (size_t)un_ * 16384 + (size_t)(chh * 64 + fr) * 128 + fq * 8;
#pragma unroll
        for (int ks = 0; ks < 4; ++ks)
#pragma unroll
          for (int n = 0; n < 4; ++n) sfr[ks * 4 + n] = *(const bf16x8*)(sp_ + n * 16 * 128 + ks * 32); }
      __syncthreads();
      hgrn_prep(z, hg_lb, tok0, hh, dir, k, qq, tot, cum, kk, total, ref, cf);
#pragma unroll
      for (int i = 0; i < 16; ++i) { const int s = qq * 16 + i; const float qv = siluf_(bf2f(cq[i])) * 0.08838834764831845f;
        *(bf16_t*)(Qd + s * H_RS + k * 2) = f2bf(qv * __expf(cum[i] - ref));
        *(bf16_t*)(Kd + s * H_RS + k * 2) = f2bf(kk[i] * __expf(ref - cum[i]));
        *(bf16_t*)(Qs + s * H_RS + k * 2) = f2bf(qv * __expf(cum[i])); }
      if (dir == 0) { float vv[16];
#pragma unroll
        for (int i = 0; i < 16; ++i) vv[i] = bf2f(cv[i]);
        pack16_store(VT + k * H_TS + qq * 32, vv); }
      __syncthreads();
      f32x4 sc[2] = {(f32x4){0.f, 0.f, 0.f, 0.f}, (f32x4){0.f, 0.f, 0.f, 0.f}};
#pragma unroll
      for (int ks = 0; ks < 4; ++ks) { const bf16x8 qf = *(const bf16x8*)(Qd + (mt * 16 + fr) * H_RS + ks * 64 + fq * 16);
#pragma unroll
        for (int n = 0; n < 2; ++n) { const bf16x8 kf = *(const bf16x8*)(Kd + (chh * 32 + n * 16 + fr) * H_RS + ks * 64 + fq * 16);
          sc[n] = __builtin_amdgcn_mfma_f32_16x16x32_bf16(kf, qf, sc[n], 0, 0, 0); } }
      const int trow = mt * 16 + fr;
#pragma unroll
      for (int n = 0; n < 2; ++n) { float pv[4];
#pragma unroll
        for (int e = 0; e < 4; ++e) { const int s = chh * 32 + n * 16 + 4 * fq + e; const bool keep = dir == 0 ? (s <= trow) : (s >= trow); pv[e] = keep ? sc[n][e] : 0.f; }
        u32x2 w; w.x = cvtpk(pv[0], pv[1]); w.y = cvtpk(pv[2], pv[3]); *(u32x2*)(Pm + trow * H_TS + (chh * 32 + n * 16 + 4 * fq) * 2) = w; }
      const int un = ((b * 4 + hh) * 2 + dir) * 128 + j;
      const bf16_t* sp = ST + (size_t)un * 16384 + (size_t)(chh * 64 + fr) * 128 + fq * 8;
#pragma unroll
      for (int ks = 0; ks < 4; ++ks) { const bf16x8 qf = *(const bf16x8*)(Qs + (mt * 16 + fr) * H_RS + ks * 64 + fq * 16);
#pragma unroll
        for (int n = 0; n < 4; ++n) ao[n] = __builtin_amdgcn_mfma_f32_16x16x32_bf16(sfr[ks * 4 + n], qf, ao[n], 0, 0, 0); }
      __syncthreads();
#pragma unroll
      for (int ks = 0; ks < 2; ++ks) { const bf16x8 pf = *(const bf16x8*)(Pm + (mt * 16 + fr) * H_TS + ks * 64 + fq * 16);
#pragma unroll
        for (int n = 0; n < 4; ++n) { const bf16x8 vf = *(const bf16x8*)(VT + (chh * 64 + n * 16 + fr) * H_TS + ks * 64 + fq * 16);
          ao[n] = __builtin_amdgcn_mfma_f32_16x16x32_bf16(vf, pf, ao[n], 0, 0, 0); } }
    }
    float ss = 0.f;
#pragma unroll
    for (int n = 0; n < 4; ++n) ss += ao[n][0] * ao[n][0] + ao[n][1] * ao[n][1] + ao[n][2] * ao[n][2] + ao[n][3] * ao[n][3];
    ss += shfl_xor_f(ss, 16); ss += shfl_xor_f(ss, 32);
    if (fq == 0) ssq[chh * 64 + mt * 16 + fr] = ss;
    __syncthreads();
    const float rstd = rsqrtf((ssq[mt * 16 + fr] + ssq[64 + mt * 16 + fr]) * (1.f / 128.f) + EPS);
    const int tok = tok0 + mt * 16 + fr;
#pragma unroll
    for (int n = 0; n < 4; ++n) { const int v0 = chh * 64 + n * 16 + 4 * fq;
      const f32x4 gn = *(const f32x4*)(hg_norm + hh * 128 + v0);
      const u32x2 gz = *(const u32x2*)(z + (size_t)tok * ZLD + 2048 + hh * 128 + v0);
      const float g0 = siluf_(__uint_as_float(gz.x << 16)), g1 = siluf_(__uint_as_float(gz.x & 0xffff0000u)), g2 = siluf_(__uint_as_float(gz.y << 16)), g3 = siluf_(__uint_as_float(gz.y & 0xffff0000u));
      u32x2 w; w.x = cvtpk(ao[n][0] * rstd * gn[0] * g0, ao[n][1] * rstd * gn[1] * g1); w.y = cvtpk(ao[n][2] * rstd * gn[2] * g2, ao[n][3] * rstd * gn[3] * g3);
      *(u32x2*)(mix + (size_t)tok * DM + hh * 128 + v0) = w; }
  }
}

DEV void mla_phase(char* lds, const bf16_t* __restrict__ QF, const bf16_t* __restrict__ KVF, const bf16_t* __restrict__ Z, bf16_t* __restrict__ mix) {
  const int wid = tidx() >> 6, lane = tidx() & 63, r32 = lane & 31, hi = lane >> 5;
  for (int u = vblock(); u < 512; u += gridDim.x) {
    const int bh = u >> 5, qb = u & 31, b = bh >> 2, h = bh & 3;
    const size_t t0 = (size_t)b * SEQ;
    f32x16 o[4];
    attn_body_s<12, true>(QF + (t0 + qb * 256) * 768 + h * 192, 768, KVF + t0 * 1024 + h * 256, 1024, Z + t0 * ZLD + 3200, ZLD, KVF + t0 * 1024 + h * 256 + 128, 1024, SEQ, lds, o);
    bf16_t* op = mix + (t0 + qb * 256 + wid * 32) * DM + 512 + h * 128 + r32; asm volatile("" : "+v"(op));
#pragma unroll
    for (int r = 0; r < 16; ++r) { const int orow = crow(r, hi);
#pragma unroll
      for (int d0 = 0; d0 < 4; ++d0) op[(size_t)orow * DM + d0 * 32] = f2bf(o[d0][r]); }
  }
}
DEV void diff_phase(char* lds, const bf16_t* __restrict__ QKV, const Params& p, float* __restrict__ scr, bf16_t* __restrict__ mix) {
  const int wid = tidx() >> 6, lane = tidx() & 63, r32 = lane & 31, hi = lane >> 5;
  float d1 = p.lq1[lane] * p.lk1[lane], d2 = p.lq2[lane] * p.lk2[lane];
#pragma unroll
  for (int o = 32; o >= 1; o >>= 1) { d1 += shfl_xor_f(d1, o); d2 += shfl_xor_f(d2, o); }
  const float lam = __expf(d1) - __expf(d2) + LAMBDA_INIT;
  float* myscr = scr + (size_t)blockIdx.x * 32768 + wid * 4096 + lane;
  for (int u = vblock(); u < 1024; u += gridDim.x) {
    const int bh = u >> 5, qb = u & 31, b = bh >> 3, h = bh & 7;
    const size_t t0 = (size_t)b * SEQ;
    const bf16_t* base = QKV + t0 * 3072;
    f32x16 o[4];
#pragma unroll 1
    for (int c = 0; c < 2; ++c) {
      attn_body<4, true>(base + (size_t)(qb * 256) * 3072 + h * 128 + c * 64, 3072, nullptr, 0, base + 1024 + h * 128 + c * 64, 3072, base + 2048 + h * 128, 3072, SEQ, lds, o);
      if (c == 0) {
        float* wrscr = myscr; asm volatile("" : "+v"(wrscr));
#pragma unroll
        for (int d0 = 0; d0 < 4; ++d0)
#pragma unroll
          for (int r = 0; r < 16; ++r) wrscr[(d0 * 16 + r) * 64] = o[d0][r];
      }
    }
    float ss[16];
#pragma unroll
    for (int r = 0; r < 16; ++r) ss[r] = 0.f;
    const float* rdscr = myscr; asm volatile("" : "+v"(rdscr));
#pragma unroll
    for (int d0 = 0; d0 < 4; ++d0)
#pragma unroll
      for (int r = 0; r < 16; ++r) { const float v = rdscr[(d0 * 16 + r) * 64] - lam * o[d0][r]; o[d0][r] = v; ss[r] += v * v; }
#pragma unroll
    for (int r = 0; r < 16; ++r) {
#pragma unroll
      for (int s = 16; s >= 1; s >>= 1) ss[r] += shfl_xor_f(ss[r], s);
      ss[r] = rsqrtf(ss[r] * (1.f / 128.f) + EPS) * (1.f - LAMBDA_INIT); }
    bf16_t* op = mix + (t0 + qb * 256 + wid * 32) * DM + h * 128 + r32; asm volatile("" : "+v"(op));
#pragma unroll
    for (int d0 = 0; d0 < 4; ++d0) { const float gn = p.diff_norm[d0 * 32 + r32];
#pragma unroll
      for (int r = 0; r < 16; ++r) op[(size_t)crow(r, hi) * DM + d0 * 32] = f2bf(o[d0][r] * ss[r] * gn); }
  }
}


__global__ void __launch_bounds__(NTHR) fwd_megakernel(Params p) {
  extern __shared__ __attribute__((aligned(16))) char lds[];
  cg::grid_group grid = cg::this_grid();
  __shared__ __attribute__((aligned(16))) unsigned xb_words[4];
  if (threadIdx.x < 4) xb_words[threadIdx.x] = 0u;
  __syncthreads();
  (void)xcd_barrier_post((unsigned*)(p.ws + WS_BAR), (volatile LAS unsigned*)&xb_words[0]);
  unsigned char* ws = p.ws;
  bf16_t* W_in0 = (bf16_t*)(ws + WS_WIN0); bf16_t* W_uq = (bf16_t*)(ws + WS_WUQ); bf16_t* W_ukv = (bf16_t*)(ws + WS_WUKV); bf16_t* W_out0 = (bf16_t*)(ws + WS_WOUT0);
  bf16_t* W_gu = (bf16_t*)(ws + WS_WGU); bf16_t* W_dn = (bf16_t*)(ws + WS_WDN); bf16_t* W_cin = (bf16_t*)(ws + WS_WCIN); bf16_t* W_cout = (bf16_t*)(ws + WS_WCOUT);
  float* COS = (float*)(ws + WS_COS); float* SIN = (float*)(ws + WS_SIN); float* HD = (float*)(ws + WS_HD);
  bf16_t* HB = (bf16_t*)(ws + WS_HB); bf16_t* Z = (bf16_t*)(ws + WS_Z); bf16_t* CN = (bf16_t*)(ws + WS_CN); bf16_t* QF = (bf16_t*)(ws + WS_QF); bf16_t* KVF = (bf16_t*)(ws + WS_KVF);
  bf16_t* ST = (bf16_t*)p.out;
  float* SCR = (float*)(ws + WS_SCR);
  constexpr size_t WGU_E = (size_t)5632 * 1024, WDN_E = (size_t)1024 * 2816;

#define GSYNC() do { XcdBarrier xb_; xb_.bar = (unsigned*)(p.ws + WS_BAR); xb_.x = xb_xcc_id(); xb_.st = (volatile LAS unsigned*)&xb_words[0]; xcd_barrier(xb_); } while (0)
  {
    const int gtid = blockIdx.x * NTHR + tidx(), gsz = gridDim.x * NTHR;
    for (int i = gtid; i < SEQ * 32; i += gsz) { const int pos = i >> 5, jf = i & 31; const float ang = (float)pos * p.inv[jf];
      const double a = (double)ang; const double n = rint(a * 0.15915494309189535); const float r = (float)(a - n * 6.283185307179586);
      COS[i] = __cosf(r); SIN[i] = __sinf(r); }
    for (int i = gtid; i < 64 * 1024; i += gsz) W_in0[(size_t)3264 * 1024 + i] = 0;
    int xrot = 0;
    xpose_job(lds, p.ab_w_in, 1024, 3264, W_in0, 0, xrot);
    xpose_job(lds, p.w_uq, 384, 768, W_uq, 0, xrot);
    xpose_job(lds, p.w_ukv, 256, 1024, W_ukv, 0, xrot);
    xpose_job(lds, p.ab_w_out, 1024, 1024, W_out0, 0, xrot);
    for (int l = 0; l < 2; ++l) {
      xpose_job(lds, p.w_gate + (size_t)l * 1024 * FH, 1024, FH, W_gu + l * WGU_E, 1, xrot);
      xpose_job(lds, p.w_up + (size_t)l * 1024 * FH, 1024, FH, W_gu + l * WGU_E, 2, xrot);
      xpose_job(lds, p.w_down + (size_t)l * FH * 1024, FH, 1024, W_dn + l * WDN_E, 0, xrot);
    }
    xpose_job(lds, p.c_w_in, 1024, 3072, W_cin, 0, xrot);
    xpose_job(lds, p.c_w_out, 1024, 1024, W_cout, 0, xrot);
    rms_rows_bf16(p.x, p.norm_attn, HB);
  }
  asm volatile("s_waitcnt vmcnt(0)" ::: "memory"); grid.sync();
  { EpiStore e{Z, ZLD, 1, COS, SIN, 1}; gemm_phase<EpiStore, true>(lds, HB, 1024, W_in0, 1024, 1024, 13, 128 * 13, e); }
  GSYNC();
  cnorm_rows(Z, p.q_norm, p.kv_norm, CN);
  hgrn_stepA(lds, Z, p.hg_lb, ST, HD);
  GSYNC();
  hgrn_stepB(ST, HD);
  { EpiStore e{QF, 768, 2, COS, SIN, 0}; gemm_phase<EpiStore, false>(lds, CN, 640, W_uq, 384, 384, 3, 128 * 3, e); }
  { EpiStore e{KVF, 1024, 0, COS, SIN, 0}; gemm_phase<EpiStore, false>(lds, CN + 384, 640, W_ukv, 256, 256, 4, 128 * 4, e); }
  GSYNC();
  mla_phase(lds, QF, KVF, Z, HB);
  hgrn_stepC(lds, Z, p.hg_lb, p.hg_norm, ST, HB);
  GSYNC();
  { EpiResid e{p.x, p.out}; gemm_phase(lds, HB, 1024, W_out0, 1024, 1024, 4, 128 * 4, e); }
  GSYNC();
  for (int layer = 0; layer < 2; ++layer) {
    if (layer == 1) {
      rms_rows_bf16(p.out, p.norm_attn + 1024, HB);
      GSYNC();
      { EpiStore e{Z, 3072, 3, COS, SIN, 1}; gemm_phase<EpiStore, true>(lds, HB, 1024, W_cin, 1024, 1024, 12, 128 * 12, e); }
      GSYNC();
      diff_phase(lds, Z, p, SCR, HB);
      GSYNC();
      { EpiResid e{p.out, p.out}; gemm_phase(lds, HB, 1024, W_cout, 1024, 1024, 4, 128 * 4, e); }
      GSYNC();
    }
    rms_rows_bf16(p.out, p.norm_ffn + layer * 1024, HB);
    GSYNC();
    { EpiSwiglu e{Z}; gemm_phase<EpiSwiglu, true>(lds, HB, 1024, W_gu + layer * WGU_E, 1024, 1024, 22, 128 * 22, e); }
    GSYNC();
    { EpiResid e{p.out, p.out}; gemm_phase(lds, Z, FH, W_dn + layer * WDN_E, FH, FH, 4, 128 * 4, e); }
    GSYNC();
  }
  rms_rows_f32(p.out, p.final_norm);
}

extern "C" void kernel_launch(void* const* d_in, const int* in_sizes, int n_in, void* d_out, int out_size, void* d_ws, size_t ws_size, hipStream_t stream) {
  static int grid_blocks = 0;
  if (grid_blocks == 0) {
    if (n_in != 22 || out_size != T_TOK * DM || ws_size < WS_END) { fprintf(stderr, "kernel_launch: unexpected shapes n_in %d out %d ws %zu (need %zu)\n", n_in, out_size, ws_size, (size_t)WS_END); grid_blocks = -1; return; }
    int dev = 0, cus = 0, per_cu = 0;
    hipGetDevice(&dev);
    hipDeviceGetAttribute(&cus, hipDeviceAttributeMultiprocessorCount, dev);
    if (hipFuncSetAttribute((const void*)fwd_megakernel, hipFuncAttributeMaxDynamicSharedMemorySize, LDS_BYTES) != hipSuccess) { fprintf(stderr, "kernel_launch: hipFuncSetAttribute failed\n"); grid_blocks = -1; return; }
    if (hipOccupancyMaxActiveBlocksPerMultiprocessor(&per_cu, (const void*)fwd_megakernel, NTHR, LDS_BYTES) != hipSuccess || per_cu < 1) { fprintf(stderr, "kernel_launch: occupancy query gives %d\n", per_cu); per_cu = 1; }
    (void)hipGetLastError();
    grid_blocks = cus;
    if (grid_blocks % 8) grid_blocks -= grid_blocks % 8;
  }
  if (grid_blocks < 0) return;
  Params p{};
  const float** pf = (const float**)&p;
  for (int i = 0; i < 22; ++i) pf[i] = (const float*)d_in[i];
  p.out = (float*)d_out; p.ws = (unsigned char*)d_ws;
  for (int j = 0; j < 32; ++j) p.inv[j] = (float)(1.0 / pow(10000.0, (double)j / 32.0));
  if (hipMemsetAsync((char*)d_ws + WS_BAR, 0, XCD_BAR_WORDS * 4, stream) != hipSuccess) { fprintf(stderr, "kernel_launch: memset of the barrier words failed\n"); return; }
  void* args[] = {&p};
  hipError_t e = hipLaunchCooperativeKernel((const void*)fwd_megakernel, dim3(grid_blocks), dim3(NTHR), args, LDS_BYTES, stream);
  if (e != hipSuccess) fprintf(stderr, "kernel_launch: cooperative launch failed: %s (grid %d)\n", hipGetErrorString(e), grid_blocks);
}
```

```cpp
#include <hip/hip_runtime.h>
#include <hip/hip_cooperative_groups.h>
#include <cstdio>
#include <cstdint>
#include <cmath>
namespace cg = cooperative_groups;

typedef unsigned short bf16_t;
typedef short bf16x8 __attribute__((ext_vector_type(8)));
typedef short s16x4 __attribute__((ext_vector_type(4)));
typedef float f32x4 __attribute__((ext_vector_type(4)));
typedef float f32x16 __attribute__((ext_vector_type(16)));
typedef unsigned u32x4 __attribute__((ext_vector_type(4)));
typedef unsigned u32x2 __attribute__((ext_vector_type(2)));
#define DEV __device__ __forceinline__

constexpr int T_TOK = 32768, SEQ = 8192, NB = 4, DM = 1024, FH = 2816;
constexpr int ZLD = 3328;
constexpr int NTHR = 512;
constexpr float EPS = 1e-6f;
constexpr float LAMBDA_INIT = 0.35550906759096926f;

constexpr size_t al256(size_t x) { return (x + 255) / 256 * 256; }
constexpr size_t WS_WIN0 = 0;
constexpr size_t WS_WUQ = WS_WIN0 + al256((size_t)ZLD * 1024 * 2);
constexpr size_t WS_WUKV = WS_WUQ + al256((size_t)768 * 384 * 2);
constexpr size_t WS_WOUT0 = WS_WUKV + al256((size_t)1024 * 256 * 2);
constexpr size_t WS_WGU = WS_WOUT0 + al256((size_t)1024 * 1024 * 2);
constexpr size_t WS_WDN = WS_WGU + 2 * al256((size_t)5632 * 1024 * 2);
constexpr size_t WS_WCIN = WS_WDN + 2 * al256((size_t)1024 * 2816 * 2);
constexpr size_t WS_WCOUT = WS_WCIN + al256((size_t)3072 * 1024 * 2);
constexpr size_t WS_COS = WS_WCOUT + al256((size_t)1024 * 1024 * 2);
constexpr size_t WS_SIN = WS_COS + al256((size_t)8192 * 32 * 4);
constexpr size_t WS_HD = WS_SIN + al256((size_t)8192 * 32 * 4);
constexpr size_t WS_FLAG = WS_HD + al256((size_t)4096 * 128 * 4);
constexpr size_t WS_BAR = WS_FLAG + 4096;
constexpr size_t WS_HB = WS_BAR + 16384;
constexpr size_t WS_Z = WS_HB + al256((size_t)T_TOK * 1024 * 2);
constexpr size_t WS_CN = WS_Z + al256((size_t)T_TOK * ZLD * 2);
constexpr size_t WS_QF = WS_CN + al256((size_t)T_TOK * 640 * 2);
constexpr size_t WS_KVF = WS_QF + al256((size_t)T_TOK * 768 * 2);
constexpr size_t WS_END = WS_KVF + al256((size_t)T_TOK * 1024 * 2);
constexpr size_t WS_SCR = WS_CN;

constexpr int LDS_BYTES = 131072;

struct Params {
  const float* x; const float* norm_attn; const float* norm_ffn; const float* w_gate; const float* w_up; const float* w_down;
  const float* ab_w_in; const float* hg_lb; const float* hg_norm; const float* q_norm; const float* w_uq; const float* kv_norm;
  const float* w_ukv; const float* ab_w_out; const float* c_w_in; const float* lq1; const float* lk1; const float* lq2; const float* lk2;
  const float* diff_norm; const float* c_w_out; const float* final_norm;
  float* out; unsigned char* ws;
  float inv[32];
};

DEV float bf2f(bf16_t h) { return __uint_as_float(((unsigned)h) << 16); }
typedef float f32x2_t __attribute__((ext_vector_type(2))); typedef __bf16 bf16x2_t __attribute__((ext_vector_type(2)));
DEV unsigned cvtpk(float lo, float hi) { f32x2_t v = {lo, hi}; bf16x2_t b = __builtin_convertvector(v, bf16x2_t); return __builtin_bit_cast(unsigned, b); }
DEV bf16_t f2bf(float f) { return (bf16_t)(cvtpk(f, f) & 0xffffu); }
DEV float sigmoidf_(float x) { return __builtin_amdgcn_rcpf(1.f + __expf(-x)); }
DEV float siluf_(float x) { return x * __builtin_amdgcn_rcpf(1.f + __expf(-x)); }
DEV float shfl_xor_f(float v, int o) { int self = (int)__builtin_amdgcn_mbcnt_hi(~0u, __builtin_amdgcn_mbcnt_lo(~0u, 0u)); asm volatile("" : "+v"(self));
  return __int_as_float(__builtin_amdgcn_ds_bpermute((self ^ o) << 2, __float_as_int(v))); }
DEV int tidx() { int t = threadIdx.x; asm volatile("" : "+v"(t)); return t; }
DEV int vblock() { return (blockIdx.x & 7) * (gridDim.x >> 3) + (blockIdx.x >> 3); }

#define XB_TMO      128
#define XB_XCNT(j)  (256  + 64 * (j))
#define XB_XSUB(j)  (1280 + 64 * (j))
#define XB_XGEN(j)  (2304 + 64 * (j))
#define XB_TOP      3328
#define XB_TOPGEN   3392
#define XCD_BAR_WORDS 3456
#define XB_SPIN_CAP (1u << 18)
#define LAS __attribute__((address_space(3)))

__device__ __forceinline__ unsigned xb_ld(unsigned* p)              { return __hip_atomic_load(p, __ATOMIC_RELAXED, __HIP_MEMORY_SCOPE_AGENT); }
__device__ __forceinline__ unsigned xb_add(unsigned* p, unsigned v) { return __hip_atomic_fetch_add(p, v, __ATOMIC_RELAXED, __HIP_MEMORY_SCOPE_AGENT); }
__device__ __forceinline__ unsigned xb_xcc_id() { return (unsigned)__builtin_amdgcn_s_getreg((3 << 11) | 20) & 0xFu; }
#define XB_SPIN(cond, bar) do { unsigned _sp = 0; while (cond) { __builtin_amdgcn_s_sleep(1); \
    if ((++_sp & 255u) == 0u) { if (xb_ld(&(bar)[XB_TMO])) break; if (_sp > XB_SPIN_CAP) { atomicAdd(&(bar)[XB_TMO], 1u); break; } } } } while (0)

struct XcdBarrier {
    unsigned* bar; unsigned x;
    volatile LAS unsigned* st;
};

__device__ __forceinline__ XcdBarrier xcd_barrier_post(unsigned* bar, volatile LAS unsigned* st) {
    XcdBarrier b; b.bar = bar; b.x = xb_xcc_id(); b.st = st;
    if (threadIdx.x == 0) (void)xb_add(&bar[XB_XCNT(b.x)], 1u);
    return b;
}
__device__ __forceinline__ void xcd_barrier_complete(unsigned* bar, unsigned x, unsigned& nloc, unsigned& nx) {
    const unsigned G = gridDim.x * gridDim.y * gridDim.z;
    unsigned sum, cnt, mine, sp = 0u;
    for (;;) {
        sum = 0u; cnt = 0u; mine = 0u;
#pragma unroll
        for (unsigned j = 0; j < 16; ++j) { const unsigned c = xb_ld(&bar[XB_XCNT(j)]); sum += c; cnt += (c > 0u) ? 1u : 0u; mine = (j == x) ? c : mine; }
        if (sum == G) break;
        __builtin_amdgcn_s_sleep(1);
        if ((++sp & 255u) == 0u) { if (xb_ld(&bar[XB_TMO])) break; if (sp > XB_SPIN_CAP) { atomicAdd(&bar[XB_TMO], 1u); break; } }
    }
    nloc = mine > 0u ? mine : 1u; nx = cnt > 0u ? cnt : 1u;
}

__device__ __forceinline__ void xcd_barrier(const XcdBarrier& b) {
    asm volatile("s_waitcnt vmcnt(0)" ::: "memory");
    __syncthreads();
    if (threadIdx.x == 0) {
        unsigned* bar = b.bar;
        __builtin_amdgcn_s_waitcnt(0);
        unsigned nloc = b.st[0], nx = b.st[1];
        if (nloc == 0u) { xcd_barrier_complete(bar, b.x, nloc, nx); b.st[0] = nloc; b.st[1] = nx; }
        const unsigned old = xb_add(&bar[XB_XSUB(b.x)], 1u);
        const unsigned gen = old / nloc;
        if (old + 1u == (gen + 1u) * nloc) {
            __builtin_amdgcn_fence(__ATOMIC_RELEASE, "agent");
            asm volatile("s_waitcnt vmcnt(0)" ::: "memory");
            const unsigned og = xb_add(&bar[XB_TOP], 1u);
            const unsigned tg = og / nx;
            if (og + 1u == (tg + 1u) * nx) xb_add(&bar[XB_TOPGEN], 1u);
            else XB_SPIN(xb_ld(&bar[XB_TOPGEN]) == tg, bar);
            __builtin_amdgcn_fence(__ATOMIC_ACQUIRE, "agent");
            xb_add(&bar[XB_XGEN(b.x)], 1u);
            asm volatile("s_waitcnt vmcnt(0)" ::: "memory");
        } else {
            XB_SPIN(xb_ld(&bar[XB_XGEN(b.x)]) == gen, bar);
            __builtin_amdgcn_fence(__ATOMIC_ACQUIRE, "agent");
            asm volatile("s_waitcnt vmcnt(0)" ::: "memory");
        }
    }
    __syncthreads();
}


DEV void xpose_job(char* lds, const float* __restrict__ src, int K, int N, bf16_t* __restrict__ dst, int mode, int& rot) {
  float* tile = (float*)lds;
  const int nk = K >> 6, nn = (N + 255) >> 8, nt = nk * nn, tid = tidx();
  const int kr = tid >> 6, nl = tid & 63;
  int t0 = (int)blockIdx.x - rot; if (t0 < 0) t0 += gridDim.x;
  rot = (rot + nt) % (int)gridDim.x;
  for (int t = t0; t < nt; t += gridDim.x) {
    const int tk = t / nn, tn = t - tk * nn, k0 = tk * 64, n0 = tn * 256;
    float v[32];
#pragma unroll
    for (int c = 0; c < 4; ++c)
#pragma unroll
      for (int i = 0; i < 8; ++i) { const int gn = n0 + c * 64 + nl; v[c * 8 + i] = gn < N ? src[(size_t)(k0 + kr + 8 * i) * N + gn] : 0.f; }
    __syncthreads();
#pragma unroll
    for (int c = 0; c < 4; ++c)
#pragma unroll
      for (int i = 0; i < 8; ++i) tile[(kr + 8 * i) * 257 + c * 64 + nl] = v[c * 8 + i];
    __syncthreads();
#pragma unroll
    for (int j = 0; j < 16; ++j) {
      const int n = (tid >> 5) + 16 * j, kk = (tid & 31) * 2, gn = n0 + n;
      if (gn < N) { const int dn = mode == 0 ? gn : ((gn >> 5) * 64 + (gn & 31) + (mode == 2 ? 32 : 0));
        *(unsigned*)(dst + (size_t)dn * K + k0 + kk) = cvtpk(tile[kk * 257 + n], tile[(kk + 1) * 257 + n]); }
    }
  }
  __syncthreads();
}

DEV void rms_rows_bf16(const float* __restrict__ src, const float* __restrict__ gain, bf16_t* __restrict__ dst) {
  const int wid = tidx() >> 6, lane = tidx() & 63;
  f32x4 g[4];
#pragma unroll
  for (int i = 0; i < 4; ++i) g[i] = *(const f32x4*)(gain + lane * 4 + 256 * i);
  for (int row = blockIdx.x * 8 + wid; row < T_TOK; row += gridDim.x * 8) {
    const float* s = src + (size_t)row * DM; f32x4 v[4]; float ss = 0.f;
#pragma unroll
    for (int i = 0; i < 4; ++i) { v[i] = __builtin_nontemporal_load((const f32x4*)(s + lane * 4 + 256 * i)); ss += v[i][0] * v[i][0] + v[i][1] * v[i][1] + v[i][2] * v[i][2] + v[i][3] * v[i][3]; }
#pragma unroll
    for (int o = 32; o >= 1; o >>= 1) ss += shfl_xor_f(ss, o);
    const float r = rsqrtf(ss * (1.f / DM) + EPS);
#pragma unroll
    for (int i = 0; i < 4; ++i) { u32x2 w; w.x = cvtpk(v[i][0] * r * g[i][0], v[i][1] * r * g[i][1]); w.y = cvtpk(v[i][2] * r * g[i][2], v[i][3] * r * g[i][3]);
      *(u32x2*)(dst + (size_t)row * DM + lane * 4 + 256 * i) = w; }
  }
}
DEV void rms_rows_f32(float* __restrict__ buf, const float* __restrict__ gain) {
  const int wid = tidx() >> 6, lane = tidx() & 63;
  f32x4 g[4];
#pragma unroll
  for (int i = 0; i < 4; ++i) g[i] = *(const f32x4*)(gain + lane * 4 + 256 * i);
  for (int row = blockIdx.x * 8 + wid; row < T_TOK; row += gridDim.x * 8) {
    float* s = buf + (size_t)row * DM; f32x4 v[4]; float ss = 0.f;
#pragma unroll
    for (int i = 0; i < 4; ++i) { v[i] = *(const f32x4*)(s + lane * 4 + 256 * i); ss += v[i][0] * v[i][0] + v[i][1] * v[i][1] + v[i][2] * v[i][2] + v[i][3] * v[i][3]; }
#pragma unroll
    for (int o = 32; o >= 1; o >>= 1) ss += shfl_xor_f(ss, o);
    const float r = rsqrtf(ss * (1.f / DM) + EPS);
#pragma unroll
    for (int i = 0; i < 4; ++i) { f32x4 w = v[i] * r * g[i]; *(f32x4*)(s + lane * 4 + 256 * i) = w; }
  }
}
DEV void cnorm_rows(const bf16_t* __restrict__ z, const float* __restrict__ qg, const float* __restrict__ kg, bf16_t* __restrict__ cn) {
  const int wid = tidx() >> 6, lane = tidx() & 63;
  for (int row = blockIdx.x * 8 + wid; row < T_TOK; row += gridDim.x * 8) {
    const bf16_t* zr = z + (size_t)row * ZLD; float a[6], c[4]; float sa = 0.f, sc = 0.f;
#pragma unroll
    for (int i = 0; i < 6; ++i) { a[i] = bf2f(zr[2560 + lane + 64 * i]); sa += a[i] * a[i]; }
#pragma unroll
    for (int i = 0; i < 4; ++i) { c[i] = bf2f(zr[2944 + lane + 64 * i]); sc += c[i] * c[i]; }
#pragma unroll
    for (int o = 32; o >= 1; o >>= 1) { sa += shfl_xor_f(sa, o); sc += shfl_xor_f(sc, o); }
    const float ra = rsqrtf(sa * (1.f / 384.f) + EPS), rc = rsqrtf(sc * (1.f / 256.f) + EPS);
    bf16_t* o = cn + (size_t)row * 640;
#pragma unroll
    for (int i = 0; i < 6; ++i) o[lane + 64 * i] = f2bf(a[i] * ra * qg[lane + 64 * i]);
#pragma unroll
    for (int i = 0; i < 4; ++i) o[384 + lane + 64 * i] = f2bf(c[i] * rc * kg[lane + 64 * i]);
  }
}

constexpr int G_TILEB = 256 * 128, G_STAGEB = 2 * G_TILEB;

struct EpiStore {
  bf16_t* C; int ldc; int mode; const float* cs; const float* sn; int perm;
  DEV void operator()(f32x4 (&acc)[8][4], int row0, int col0, int fr, int fq) const {
    const int g = col0 >> 6; const bool rope = mode == 1 ? (g == 50) : mode == 2 ? (g % 3 == 2) : mode == 3 ? (g < 32) : false;
#pragma unroll
    for (int m = 0; m < 8; ++m) {
      const int row = row0 + m * 16 + fr;
      if (mode == 2) {
#pragma unroll
        for (int n = 0; n < 4; ++n) acc[m][n] = acc[m][n] * 0.10411754627697264f; }
      if (mode == 3 && col0 < 1024) {
#pragma unroll
        for (int n = 0; n < 4; ++n) acc[m][n] = acc[m][n] * 0.18033688011112042f; }
      if (rope) { const int pos = row & (SEQ - 1);
#pragma unroll
        for (int n = 0; n < 2; ++n) { const int j0 = perm ? 8 * fq + 4 * n : n * 16 + 4 * fq;
          const f32x4 c = *(const f32x4*)(cs + pos * 32 + j0), s = *(const f32x4*)(sn + pos * 32 + j0);
          const f32x4 x1 = acc[m][n], x2 = acc[m][n + 2]; acc[m][n] = x1 * c - x2 * s; acc[m][n + 2] = x2 * c + x1 * s; } }
      if (perm) {
#pragma unroll
        for (int gg = 0; gg < 2; ++gg) { u32x4 w; w.x = cvtpk(acc[m][2 * gg][0], acc[m][2 * gg][1]); w.y = cvtpk(acc[m][2 * gg][2], acc[m][2 * gg][3]);
          w.z = cvtpk(acc[m][2 * gg + 1][0], acc[m][2 * gg + 1][1]); w.w = cvtpk(acc[m][2 * gg + 1][2], acc[m][2 * gg + 1][3]);
          *(u32x4*)(C + (size_t)row * ldc + col0 + 32 * gg + 8 * fq) = w; }
      } else {
#pragma unroll
        for (int n = 0; n < 4; ++n) { u32x2 w; w.x = cvtpk(acc[m][n][0], acc[m][n][1]); w.y = cvtpk(acc[m][n][2], acc[m][n][3]);
          *(u32x2*)(C + (size_t)row * ldc + col0 + n * 16 + 4 * fq) = w; }
      }
    }
  }
};
struct EpiResid {
  const float* res; float* out;
  DEV void operator()(f32x4 (&acc)[8][4], int row0, int col0, int fr, int fq) const {
#pragma unroll
    for (int m = 0; m < 8; ++m) { const size_t ro = (size_t)(row0 + m * 16 + fr) * DM + col0 + 4 * fq;
#pragma unroll
      for (int n = 0; n < 4; ++n) { const f32x4 r = *(const f32x4*)(res + ro + n * 16); *(f32x4*)(out + ro + n * 16) = r + acc[m][n]; }
      if ((m & 3) == 3) asm volatile("" ::: "memory"); }
  }
};
struct EpiSwiglu {
  bf16_t* H;
  DEV void operator()(f32x4 (&acc)[8][4], int row0, int col0, int fr, int fq) const {
#pragma unroll
    for (int m = 0; m < 8; ++m) { bf16_t* hp = H + (size_t)(row0 + m * 16 + fr) * FH + (col0 >> 1) + 8 * fq;
      const f32x4 g0 = acc[m][0], u0 = acc[m][2], g1 = acc[m][1], u1 = acc[m][3]; u32x4 w;
      w.x = cvtpk(siluf_(g0[0]) * u0[0], siluf_(g0[1]) * u0[1]); w.y = cvtpk(siluf_(g0[2]) * u0[2], siluf_(g0[3]) * u0[3]);
      w.z = cvtpk(siluf_(g1[0]) * u1[0], siluf_(g1[1]) * u1[1]); w.w = cvtpk(siluf_(g1[2]) * u1[2], siluf_(g1[3]) * u1[3]);
      *(u32x4*)hp = w; }
  }
};

template <class Epi, bool PERM = false>
DEV void gemm_phase(char* lds, const bf16_t* __restrict__ A, int lda, const bf16_t* __restrict__ Bt, int ldb, int K, int nN, int nTiles, const Epi& E) {
  const int tid = tidx(), wid = tid >> 6, lane = tid & 63, wr = wid >> 2, wc = wid & 3, fr = lane & 15, fq = lane >> 4;
  const int nk = K >> 6, lrow = tid >> 3, lkc = tid & 7;
  const int hw = (((lrow >> 1) & 1) << 1) | (((lrow >> 3) & 1) << 2), hr = (((fr >> 1) & 1) << 1) | (((fr >> 3) & 1) << 2);
  const unsigned wofs = lrow * 128 + ((lkc ^ hw) << 4);
  const unsigned aofs0 = (wr * 128 + fr) * 128 + ((fq ^ hr) << 4), aofs1 = (wr * 128 + fr) * 128 + (((4 + fq) ^ hr) << 4);
  const unsigned bofs0 = G_TILEB + (wc * 64 + fr) * 128 + ((fq ^ hr) << 4), bofs1 = G_TILEB + (wc * 64 + fr) * 128 + (((4 + fq) ^ hr) << 4);
  const unsigned ao = (unsigned)(lrow * lda + lkc * 8) * 2u, bo = (unsigned)(lrow * ldb + lkc * 8) * 2u;
  const unsigned as64 = (unsigned)(64 * lda) * 2u, bs64 = (unsigned)(64 * ldb) * 2u;
  typedef __attribute__((address_space(3))) unsigned lds_u32;
  const int lrb = PERM ? ((lrow & ~31) + 8 * ((lrow & 15) >> 2) + 4 * ((lrow >> 4) & 1) + (lrow & 3)) : lrow;
  const unsigned gao = (unsigned)(lrow * lda + ((lkc ^ hw) << 3)) * 2u, gbo = (unsigned)(lrb * ldb + ((lkc ^ hw) << 3)) * 2u;
  const unsigned ldsw = (unsigned)wid * 1024u;
#define G_DMA(AB, BB, stg, k0) do { _Pragma("unroll") for (int i = 0; i < 4; ++i) { \
      __builtin_amdgcn_global_load_lds((const unsigned*)((AB) + (k0) * 2 + gao + i * as64), (lds_u32*)(lds + (stg) * G_STAGEB + ldsw + i * 8192), 16, 0, 0); \
      __builtin_amdgcn_global_load_lds((const unsigned*)((BB) + (k0) * 2 + gbo + i * bs64), (lds_u32*)(lds + (stg) * G_STAGEB + G_TILEB + ldsw + i * 8192), 16, 0, 0); } } while (0)
#define G_HALF(AO, BO, M0) do { _Pragma("unroll") for (int m = 0; m < 4; ++m) af[m] = *(const bf16x8*)(cur + (AO) + ((M0) + m) * 2048); \
      _Pragma("unroll") for (int m = 0; m < 4; ++m) _Pragma("unroll") for (int n = 0; n < 4; ++n) acc[(M0) + m][n] = __builtin_amdgcn_mfma_f32_16x16x32_bf16(bfr[n], af[m], acc[(M0) + m][n], 0, 0, 0); } while (0)
  int t = vblock();
  if (t >= nTiles) return;
  int pm = t / nN, pn = t - pm * nN;
  const char* Ab = (const char*)(A + (size_t)pm * 256 * lda);
  const char* Bb = (const char*)(Bt + (size_t)pn * 256 * ldb);
  __syncthreads();
  G_DMA(Ab, Bb, 0, 0);
  asm volatile("s_waitcnt vmcnt(0)" ::: "memory");
  __syncthreads();
  int stg = 0;
  for (;;) {
    f32x4 acc[8][4];
#pragma unroll
    for (int m = 0; m < 8; ++m)
#pragma unroll
      for (int n = 0; n < 4; ++n) acc[m][n] = (f32x4){0.f, 0.f, 0.f, 0.f};
    const int tn = t + (int)gridDim.x; const bool more = tn < nTiles;
    const int npm = more ? tn / nN : pm, npn = more ? tn - npm * nN : pn;
    const char* nAb = (const char*)(A + (size_t)npm * 256 * lda);
    const char* nBb = (const char*)(Bt + (size_t)npn * 256 * ldb);
    for (int kt = 0; kt < nk; ++kt) {
      const char* cur = lds + stg * G_STAGEB;
      if (kt + 1 < nk) G_DMA(Ab, Bb, stg ^ 1, (kt + 1) * 64);
      else if (more) G_DMA(nAb, nBb, stg ^ 1, 0);
      bf16x8 bfr[4], af[4];
#pragma unroll
      for (int n = 0; n < 4; ++n) bfr[n] = *(const bf16x8*)(cur + bofs0 + n * 2048);
#pragma unroll
      for (int m = 0; m < 4; ++m) af[m] = *(const bf16x8*)(cur + aofs0 + m * 2048);
#pragma unroll
      for (int m = 0; m < 4; ++m)
#pragma unroll
        for (int n = 0; n < 4; ++n) acc[m][n] = __builtin_amdgcn_mfma_f32_16x16x32_bf16(bfr[n], af[m], acc[m][n], 0, 0, 0);
      G_HALF(aofs0, bofs0, 4);
#pragma unroll
      for (int n = 0; n < 4; ++n) bfr[n] = *(const bf16x8*)(cur + bofs1 + n * 2048);
      G_HALF(aofs1, bofs1, 0);
      G_HALF(aofs1, bofs1, 4);
      asm volatile("s_waitcnt vmcnt(0)" ::: "memory");
      __syncthreads();
      stg ^= 1;
    }
    E(acc, pm * 256 + wr * 128, pn * 256 + wc * 64, fr, fq);
    if (!more) break;
    t = tn; pm = npm; pn = npn; Ab = nAb; Bb = nBb;
  }
#undef G_DMA
#undef G_HALF
}

#define SBAR() __builtin_amdgcn_sched_barrier(0)
DEV int crow(int r, int hi) { return (r & 3) + 8 * (r >> 2) + 4 * hi; }
constexpr float ATT_THR = 8.f;
template <int NQK> struct AttnK {
  static constexpr int DQK = NQK * 16, KROWB = DQK * 2, SHM_K = 64 * KROWB, SHM_V = 64 * 128 * 2, SHM = 2 * SHM_V + 2 * SHM_K + 8 * 64 * 4;
  static constexpr float SCALE = NQK == 12 ? 0.07216878364870323f : 0.125f;
  static constexpr int TAILC = NQK == 12 ? 128 : 0;
};
template <int NQK> DEV void partialSM(f32x16& p0, f32x16& p1, float& m_reg, float& mn, float& alpha) {
  constexpr float SC = AttnK<NQK>::SCALE, C = SC * 1.4426950408889634f;
  float pmax = p0[0];
#pragma unroll
  for (int r = 1; r < 16; ++r) pmax = fmaxf(pmax, p0[r]);
#pragma unroll
  for (int r = 0; r < 16; ++r) pmax = fmaxf(pmax, p1[r]);
  { auto rr = __builtin_amdgcn_permlane32_swap(__float_as_uint(pmax), __float_as_uint(pmax), false, false);
    pmax = fmaxf(__uint_as_float(rr[0]), __uint_as_float(rr[1])); }
  if (__builtin_expect(__all(pmax - m_reg <= ATT_THR / SC), 1)) { mn = m_reg; alpha = 1.f; }
  else { mn = fmaxf(m_reg, pmax); alpha = __builtin_amdgcn_exp2f((m_reg - mn) * C); m_reg = mn; }
  const float mnC = -mn * C;
#pragma unroll
  for (int r = 0; r < 16; ++r) p0[r] = fmaf(p0[r], C, mnC);
#pragma unroll
  for (int r = 0; r < 16; ++r) p1[r] = fmaf(p1[r], C, mnC);
#pragma unroll
  for (int r = 0; r < 16; ++r) p0[r] = __builtin_amdgcn_exp2f(p0[r]);
}
DEV void finishSM(f32x16& p0, f32x16& p1, float alpha, float& l_reg, bf16x8& pa0, bf16x8& pa1, bf16x8& pa2, bf16x8& pa3) {
#pragma unroll
  for (int r = 0; r < 16; ++r) p1[r] = __builtin_amdgcn_exp2f(p1[r]);
  float ps = 0;
#pragma unroll
  for (int r = 0; r < 16; ++r) ps += p0[r];
#pragma unroll
  for (int r = 0; r < 16; ++r) ps += p1[r];
  { auto rr = __builtin_amdgcn_permlane32_swap(__float_as_uint(ps), __float_as_uint(ps), false, false);
    ps = __uint_as_float(rr[0]) + __uint_as_float(rr[1]); }
  l_reg = l_reg * alpha + ps;
#define PK4(P, BASE, OUT) do { unsigned a0 = cvtpk(P[BASE + 0], P[BASE + 1]), a1 = cvtpk(P[BASE + 2], P[BASE + 3]);   \
    unsigned b0 = cvtpk(P[BASE + 4], P[BASE + 5]), b1 = cvtpk(P[BASE + 6], P[BASE + 7]);                              \
    auto r0 = __builtin_amdgcn_permlane32_swap(a0, b0, false, false); auto r1 = __builtin_amdgcn_permlane32_swap(a1, b1, false, false); \
    u32x4 w = {r0[0], r1[0], r0[1], r1[1]}; OUT = *reinterpret_cast<bf16x8*>(&w); } while (0)
  PK4(p0, 0, pa0); PK4(p0, 8, pa1); PK4(p1, 0, pa2); PK4(p1, 8, pa3);
#undef PK4
}
template <int NQK> DEV void qkt(f32x16& p0, f32x16& p1, const char* Ks, const bf16x8* qr, int r32, int hi) {
  constexpr int KROWB = AttnK<NQK>::KROWB;
  p0 = f32x16{}; p1 = f32x16{};
#pragma unroll
  for (int d0 = 0; d0 < NQK; ++d0) { const int cb = (d0 * 16 + hi * 8) * 2;
    const bf16x8 b0 = *reinterpret_cast<const bf16x8*>(Ks + r32 * KROWB + (cb ^ ((r32 & 7) << 4)));
    const bf16x8 b1 = *reinterpret_cast<const bf16x8*>(Ks + (32 + r32) * KROWB + (cb ^ ((r32 & 7) << 4)));
    p0 = __builtin_amdgcn_mfma_f32_32x32x16_bf16(b0, qr[d0], p0, 0, 0, 0);
    p1 = __builtin_amdgcn_mfma_f32_32x32x16_bf16(b1, qr[d0], p1, 0, 0, 0); }
}
DEV int v_st(int k, int c) { const int kk = (k & ~0xC) | ((k & 4) << 1) | ((k & 8) >> 1); return ((kk >> 3) * 4 + (c >> 5)) * 512 + ((kk & 7) * 32 + (c & 31)) * 2; }
DEV int v_rd_base(int lane) { return ((lane & 3) << 3) | (((lane >> 2) & 3) << 6) | (((lane >> 4) & 1) << 5) | (((lane >> 5) & 1) << 8); }
constexpr int v_rd_off(int d0, int ks, int half) { return d0 * 512 + ks * 4096 + half * 2048; }
template <int OFF> DEV s16x4 tr_read(int vb) { s16x4 r; asm volatile("ds_read_b64_tr_b16 %0, %1 offset:%2" : "=&v"(r) : "v"(vb), "i"(OFF) : "memory"); return r; }
template <int D0> DEV void pv_one(f32x16& od, int vb, bf16x8 pa0, bf16x8 pa1, bf16x8 pa2, bf16x8 pa3) {
  const s16x4 l0 = tr_read<v_rd_off(D0, 0, 0)>(vb), h0 = tr_read<v_rd_off(D0, 0, 1)>(vb), l1 = tr_read<v_rd_off(D0, 1, 0)>(vb), h1 = tr_read<v_rd_off(D0, 1, 1)>(vb);
  const s16x4 l2 = tr_read<v_rd_off(D0, 2, 0)>(vb), h2 = tr_read<v_rd_off(D0, 2, 1)>(vb), l3 = tr_read<v_rd_off(D0, 3, 0)>(vb), h3 = tr_read<v_rd_off(D0, 3, 1)>(vb);
  asm volatile("s_waitcnt lgkmcnt(0)" ::: "memory"); SBAR();
#define PKV(L, H) (bf16x8){L[0], L[1], L[2], L[3], H[0], H[1], H[2], H[3]}
  od = __builtin_amdgcn_mfma_f32_32x32x16_bf16(pa0, PKV(l0, h0), od, 0, 0, 0);
  od = __builtin_amdgcn_mfma_f32_32x32x16_bf16(pa1, PKV(l1, h1), od, 0, 0, 0);
  od = __builtin_amdgcn_mfma_f32_32x32x16_bf16(pa2, PKV(l2, h2), od, 0, 0, 0);
  od = __builtin_amdgcn_mfma_f32_32x32x16_bf16(pa3, PKV(l3, h3), od, 0, 0, 0);
#undef PKV
}
DEV void pv_d0(f32x16* o, int vb, bf16x8 pa0, bf16x8 pa1, bf16x8 pa2, bf16x8 pa3) {
  pv_one<0>(o[0], vb, pa0, pa1, pa2, pa3); pv_one<1>(o[1], vb, pa0, pa1, pa2, pa3); pv_one<2>(o[2], vb, pa0, pa1, pa2, pa3); pv_one<3>(o[3], vb, pa0, pa1, pa2, pa3);
}

template <int NQK> DEV void qkt_pre(f32x16& p0, f32x16& p1, const char* Ks, const bf16x8* qr, int r32, int hi, float m_reg) {
  constexpr int KROWB = AttnK<NQK>::KROWB;
  f32x16 nm;
#pragma unroll
  for (int r = 0; r < 16; ++r) nm[r] = -m_reg;
#pragma unroll
  for (int d0 = 0; d0 < NQK; ++d0) { const int cb = (d0 * 16 + hi * 8) * 2;
    const bf16x8 b0 = *reinterpret_cast<const bf16x8*>(Ks + r32 * KROWB + (cb ^ ((r32 & 7) << 4)));
    const bf16x8 b1 = *reinterpret_cast<const bf16x8*>(Ks + (32 + r32) * KROWB + (cb ^ ((r32 & 7) << 4)));
    p0 = __builtin_amdgcn_mfma_f32_32x32x16_bf16(b0, qr[d0], d0 == 0 ? nm : p0, 0, 0, 0);
    p1 = __builtin_amdgcn_mfma_f32_32x32x16_bf16(b1, qr[d0], d0 == 0 ? nm : p1, 0, 0, 0); }
}
DEV void partialSM_pre(f32x16& p0, f32x16& p1, float& m_reg, float& alpha, bool first) {
  constexpr float THRL = ATT_THR * 1.4426950408889634f;
  float pmax = p0[0];
#pragma unroll
  for (int r = 1; r < 16; ++r) pmax = fmaxf(pmax, p0[r]);
#pragma unroll
  for (int r = 0; r < 16; ++r) pmax = fmaxf(pmax, p1[r]);
  { auto rr = __builtin_amdgcn_permlane32_swap(__float_as_uint(pmax), __float_as_uint(pmax), false, false);
    pmax = fmaxf(__uint_as_float(rr[0]), __uint_as_float(rr[1])); }
  if (__builtin_expect(!first && __all(pmax <= THRL), 1)) { alpha = 1.f; }
  else { const float delta = first ? pmax : fmaxf(pmax, 0.f); alpha = first ? 1.f : __builtin_amdgcn_exp2f(-delta); m_reg += delta;
#pragma unroll
    for (int r = 0; r < 16; ++r) p0[r] -= delta;
#pragma unroll
    for (int r = 0; r < 16; ++r) p1[r] -= delta; }
#pragma unroll
  for (int r = 0; r < 16; ++r) p0[r] = __builtin_amdgcn_exp2f(p0[r]);
}
template <int NQK, bool PRE = false>
DEV void attn_body(const bf16_t* __restrict__ Qb, int ldq, const bf16_t* __restrict__ Kn, int ldkn, const bf16_t* __restrict__ Kt, int ldkt,
                   const bf16_t* __restrict__ Vh, int ldv, int seq, char* lds, f32x16 (&o)[4]) {
  typedef AttnK<NQK> CF;
  constexpr int SHM_V = CF::SHM_V, SHM_K = CF::SHM_K, KROWB = CF::KROWB, TAILC = CF::TAILC;
  const int tid = tidx(), wid = tid >> 6, lane = tid & 63, r32 = lane & 31, hi = lane >> 5;
  char* V_lds = lds; char* K_lds = lds + 2 * SHM_V;
  float* wsl = (float*)(lds + 2 * SHM_V + 2 * SHM_K) + wid * 64; float* li_l = wsl; float* al_l = wsl + 32;
  float m_reg = PRE ? 0.f : -1e30f, l_reg = 0;
#pragma unroll
  for (int d = 0; d < 4; ++d) o[d] = f32x16{};
  bf16x8 qr[NQK];
  const bf16_t* Qw = Qb + (size_t)(wid * 32 + r32) * ldq + hi * 8;
#pragma unroll
  for (int d0 = 0; d0 < NQK; ++d0) qr[d0] = *(const bf16x8*)(Qw + d0 * 16);
  const int sr = tid >> 4, sc = (tid & 15) * 8, vst0 = v_st(sr, sc), vst1 = v_st(32 + sr, sc);
  const int tr = tid >> 3, tc = (tid & 7) * 8;
  const int kst0 = sr * KROWB + ((sc * 2) ^ ((sr & 7) << 4)), kst1 = (32 + sr) * KROWB + ((sc * 2) ^ ((sr & 7) << 4));
  const int kstt = tr * KROWB + (((TAILC + tc) * 2) ^ ((tr & 7) << 4));
  const int vb0 = (int)(uintptr_t)V_lds + v_rd_base(lane);
  bf16x8 sv0[2], sv1[2], sk0[2], sk1[2], skt[2];
#define SLOAD(i, k0) do { sv0[i] = *(const bf16x8*)(Vh + (size_t)((k0) + sr) * ldv + sc); sv1[i] = *(const bf16x8*)(Vh + (size_t)((k0) + 32 + sr) * ldv + sc); \
    if (NQK == 12) { sk0[i] = *(const bf16x8*)(Kn + (size_t)((k0) + sr) * ldkn + sc); sk1[i] = *(const bf16x8*)(Kn + (size_t)((k0) + 32 + sr) * ldkn + sc); } \
    skt[i] = *(const bf16x8*)(Kt + (size_t)((k0) + tr) * ldkt + tc); } while (0)
#define SWRITE(b, i) do { *(bf16x8*)(V_lds + (b) * SHM_V + vst0) = sv0[i]; *(bf16x8*)(V_lds + (b) * SHM_V + vst1) = sv1[i]; \
    if (NQK == 12) { *(bf16x8*)(K_lds + (b) * SHM_K + kst0) = sk0[i]; *(bf16x8*)(K_lds + (b) * SHM_K + kst1) = sk1[i]; } \
    *(bf16x8*)(K_lds + (b) * SHM_K + kstt) = skt[i]; } while (0)
#define SWAIT() do { if (NQK == 12) asm volatile("s_waitcnt vmcnt(5)" ::: "memory"); else asm volatile("s_waitcnt vmcnt(3)" ::: "memory"); } while (0)
#define RESC(a) do { if (__any((a) < 1.f)) { if (hi == 0) al_l[r32] = (a); asm volatile("s_waitcnt lgkmcnt(0)" ::: "memory"); \
    _Pragma("unroll") for (int d = 0; d < 4; ++d) _Pragma("unroll") for (int r = 0; r < 16; ++r) o[d][r] *= al_l[crow(r, hi)]; } } while (0)
#define QKT(P0, P1, KS) do { if (PRE) qkt_pre<NQK>(P0, P1, KS, qr, r32, hi, m_reg); else qkt<NQK>(P0, P1, KS, qr, r32, hi); } while (0)
#define PSM(P0, P1, MN, AL, FIRST) do { if (PRE) partialSM_pre(P0, P1, m_reg, AL, FIRST); else partialSM<NQK>(P0, P1, m_reg, MN, AL); } while (0)
  f32x16 pA0, pA1, pB0, pB1; float mnA = 0.f, mnB = 0.f, alA, alB; bf16x8 pa0, pa1, pa2, pa3; const int NT = seq / 64;
  __syncthreads();
  SLOAD(0, 0); asm volatile("s_waitcnt vmcnt(0)" ::: "memory"); SWRITE(0, 0); __syncthreads();
  QKT(pA0, pA1, K_lds); PSM(pA0, pA1, mnA, alA, true);
  SLOAD(1, 64); if (2 < NT) SLOAD(0, 128);
  SWAIT(); SWRITE(1, 1); __syncthreads();
  for (int j = 1; j + 1 < NT; j += 2) {
    SBAR(); QKT(pB0, pB1, K_lds + SHM_K);
    finishSM(pA0, pA1, alA, l_reg, pa0, pa1, pa2, pa3); SBAR();
    SLOAD(1, (j + 2) * 64); SBAR();
    pv_d0(o, vb0, pa0, pa1, pa2, pa3); PSM(pB0, pB1, mnB, alB, false);
    __syncthreads(); SWAIT(); SWRITE(0, 0);
    RESC(alB); __syncthreads();
    SBAR(); QKT(pA0, pA1, K_lds);
    finishSM(pB0, pB1, alB, l_reg, pa0, pa1, pa2, pa3); SBAR();
    if (j + 3 < NT) SLOAD(0, (j + 3) * 64); SBAR();
    pv_d0(o, vb0 + SHM_V, pa0, pa1, pa2, pa3); PSM(pA0, pA1, mnA, alA, false);
    __syncthreads(); SWAIT(); SWRITE(1, 1);
    RESC(alA); __syncthreads();
  }
  SBAR(); QKT(pB0, pB1, K_lds + SHM_K);
  finishSM(pA0, pA1, alA, l_reg, pa0, pa1, pa2, pa3); SBAR();
  pv_d0(o, vb0, pa0, pa1, pa2, pa3); PSM(pB0, pB1, mnB, alB, false);
  __syncthreads(); RESC(alB);
  finishSM(pB0, pB1, alB, l_reg, pa0, pa1, pa2, pa3); SBAR();
  pv_d0(o, vb0 + SHM_V, pa0, pa1, pa2, pa3);
  if (hi == 0) li_l[r32] = l_reg; asm volatile("s_waitcnt lgkmcnt(0)" ::: "memory");
#pragma unroll
  for (int r = 0; r < 16; ++r) { const float rl = __builtin_amdgcn_rcpf(li_l[crow(r, hi)]);
#pragma unroll
    for (int d = 0; d < 4; ++d) o[d][r] *= rl; }
#undef SLOAD
#undef SWRITE
#undef SWAIT
#undef RESC
#undef QKT
#undef PSM
}

template <int NQK, bool PRE = false>
DEV void attn_body_s(const bf16_t* __restrict__ Qb, int ldq, const bf16_t* __restrict__ Kn, int ldkn, const bf16_t* __restrict__ Kt, int ldkt,
                     const bf16_t* __restrict__ Vh, int ldv, int seq, char* lds, f32x16 (&o)[4]) {
  typedef AttnK<NQK> CF;
  constexpr int SHM_V = CF::SHM_V, SHM_K = CF::SHM_K, KROWB = CF::KROWB, TAILC = CF::TAILC;
  const int tid = tidx(), wid = tid >> 6, lane = tid & 63, r32 = lane & 31, hi = lane >> 5;
  char* V_lds = lds; char* K_lds = lds + 2 * SHM_V;
  float* wsl = (float*)(lds + 2 * SHM_V + 2 * SHM_K) + wid * 64; float* li_l = wsl; float* al_l = wsl + 32;
  float m_reg = PRE ? 0.f : -1e30f, l_reg = 0;
#pragma unroll
  for (int d = 0; d < 4; ++d) o[d] = f32x16{};
  bf16x8 qr[NQK];
  const bf16_t* Qw = Qb + (size_t)(wid * 32 + r32) * ldq + hi * 8;
#pragma unroll
  for (int d0 = 0; d0 < NQK; ++d0) qr[d0] = *(const bf16x8*)(Qw + d0 * 16);
  const int sr = tid >> 4, sc = (tid & 15) * 8, vst0 = v_st(sr, sc), vst1 = v_st(32 + sr, sc);
  const int tr = tid >> 3, tc = (tid & 7) * 8;
  const int kst0 = sr * KROWB + ((sc * 2) ^ ((sr & 7) << 4)), kst1 = (32 + sr) * KROWB + ((sc * 2) ^ ((sr & 7) << 4));
  const int kstt = tr * KROWB + (((TAILC + tc) * 2) ^ ((tr & 7) << 4));
  const int vb0 = (int)(uintptr_t)V_lds + v_rd_base(lane);
  bf16x8 sv0, sv1, sk0, sk1, skt;
#define SLOAD1(k0) do { sv0 = *(const bf16x8*)(Vh + (size_t)((k0) + sr) * ldv + sc); sv1 = *(const bf16x8*)(Vh + (size_t)((k0) + 32 + sr) * ldv + sc); \
    if (NQK == 12) { sk0 = *(const bf16x8*)(Kn + (size_t)((k0) + sr) * ldkn + sc); sk1 = *(const bf16x8*)(Kn + (size_t)((k0) + 32 + sr) * ldkn + sc); } \
    skt = *(const bf16x8*)(Kt + (size_t)((k0) + tr) * ldkt + tc); } while (0)
#define SWRITE1(b) do { *(bf16x8*)(V_lds + (b) * SHM_V + vst0) = sv0; *(bf16x8*)(V_lds + (b) * SHM_V + vst1) = sv1; \
    if (NQK == 12) { *(bf16x8*)(K_lds + (b) * SHM_K + kst0) = sk0; *(bf16x8*)(K_lds + (b) * SHM_K + kst1) = sk1; } \
    *(bf16x8*)(K_lds + (b) * SHM_K + kstt) = skt; } while (0)
  f32x16 p0, p1; float mn, al; bf16x8 pa0, pa1, pa2, pa3; const int NT = seq / 64;
  __syncthreads();
  SLOAD1(0); SWRITE1(0); SLOAD1(64);
  __syncthreads();
  for (int j = 0; j < NT; ++j) {
    const int b = j & 1;
    if (j + 1 < NT) { SWRITE1(b ^ 1); if (j + 2 < NT) SLOAD1((j + 2) * 64); }
    if (PRE) { qkt_pre<NQK>(p0, p1, K_lds + b * SHM_K, qr, r32, hi, m_reg); partialSM_pre(p0, p1, m_reg, al, j == 0); }
    else { qkt<NQK>(p0, p1, K_lds + b * SHM_K, qr, r32, hi); partialSM<NQK>(p0, p1, m_reg, mn, al); }
    if (__any(al < 1.f)) { if (hi == 0) al_l[r32] = al; asm volatile("s_waitcnt lgkmcnt(0)" ::: "memory");
#pragma unroll
      for (int d = 0; d < 4; ++d)
#pragma unroll
        for (int r = 0; r < 16; ++r) o[d][r] *= al_l[crow(r, hi)]; }
    finishSM(p0, p1, al, l_reg, pa0, pa1, pa2, pa3);
    pv_d0(o, vb0 + b * SHM_V, pa0, pa1, pa2, pa3);
    __syncthreads();
  }
  if (hi == 0) li_l[r32] = l_reg; asm volatile("s_waitcnt lgkmcnt(0)" ::: "memory");
#pragma unroll
  for (int r = 0; r < 16; ++r) { const float rl = __builtin_amdgcn_rcpf(li_l[crow(r, hi)]);
#pragma unroll
    for (int d = 0; d < 4; ++d) o[d][r] *= rl; }
#undef SLOAD1
#undef SWRITE1
}

constexpr int H_RS = 272;
constexpr int H_TS = 144;
DEV void hgrn_prep(const bf16_t* __restrict__ z, const float* __restrict__ hg_lb, int tok0, int hh, int dir, int k, int qq, float* tot,
                   float (&cum)[16], float (&kk)[16], float& total, float& ref, const bf16_t (&fraw)[16]) {
  const int ch = hh * 128 + k;
  const float a0 = hg_lb[dir * 1024 + ch], a1 = hg_lb[dir * 1024 + 512 + ch];
  const float lb = 1.f / (1.f + __expf(a1 - a0));
#pragma unroll
  for (int i = 0; i < 16; ++i) { const float fp = bf2f(fraw[i]); const float sg = sigmoidf_(fp);
    cum[i] = __logf(lb + (1.f - lb) * sg); kk[i] = (1.f - lb) * (1.f - sg); }
  if (dir == 0) {
#pragma unroll
    for (int i = 1; i < 16; ++i) cum[i] += cum[i - 1];
    tot[qq * 128 + k] = cum[15];
  } else {
#pragma unroll
    for (int i = 14; i >= 0; --i) cum[i] += cum[i + 1];
    tot[qq * 128 + k] = cum[0];
  }
  __syncthreads();
  const float t0 = tot[k], t1 = tot[128 + k], t2 = tot[256 + k], t3 = tot[384 + k];
  total = (t0 + t1) + (t2 + t3);
  float offs;
  if (dir == 0) { offs = (qq > 0 ? t0 : 0.f) + (qq > 1 ? t1 : 0.f) + (qq > 2 ? t2 : 0.f); ref = t0 + t1; }
  else { offs = (qq < 3 ? t3 : 0.f) + (qq < 2 ? t2 : 0.f) + (qq < 1 ? t1 : 0.f); ref = t2 + t3; }
#pragma unroll
  for (int i = 0; i < 16; ++i) cum[i] += offs;
}
DEV void hgrn_load16(const bf16_t* __restrict__ p, bf16_t (&r)[16]) {
#pragma unroll
  for (int i = 0; i < 16; ++i) r[i] = p[(size_t)i * ZLD];
}
DEV void pack16_store(char* dst, const float (&v)[16]) {
  u32x4 w0, w1;
  w0.x = cvtpk(v[0], v[1]); w0.y = cvtpk(v[2], v[3]); w0.z = cvtpk(v[4], v[5]); w0.w = cvtpk(v[6], v[7]);
  w1.x = cvtpk(v[8], v[9]); w1.y = cvtpk(v[10], v[11]); w1.z = cvtpk(v[12], v[13]); w1.w = cvtpk(v[14], v[15]);
  *(u32x4*)dst = w0; *(u32x4*)(dst + 16) = w1;
}
DEV void hgrn_stepA(char* lds, const bf16_t* __restrict__ z, const float* __restrict__ hg_lb, bf16_t* __restrict__ ST, float* __restrict__ HD) {
  const int tid = tidx(), wid = tid >> 6, lane = tid & 63, fr = lane & 15, fq = lane >> 4, k = tid & 127, qq = tid >> 7;
  char* KdT = lds;
  char* VT = lds + 128 * H_TS;
  float* tot = (float*)(lds + 2 * 128 * H_TS);
  bf16_t pf[16], pv[16];
#define HA_LOAD(U) do { const int j_ = (U) & 127, r_ = (U) >> 7, d_ = r_ & 1, h_ = (r_ >> 1) & 3, b_ = r_ >> 3; \
    const bf16_t* zb_ = z + (size_t)(b_ * SEQ + j_ * 64 + qq * 16) * ZLD + h_ * 128 + k; hgrn_load16(zb_ + 512 + d_ * 512, pf); hgrn_load16(zb_ + 1536, pv); } while (0)
  { const int u0 = vblock(); if (u0 < 4096) HA_LOAD(u0); }
  for (int u = vblock(); u < 4096; u += gridDim.x) {
    const int j = u & 127, rest = u >> 7, dir = rest & 1, hh = (rest >> 1) & 3, b = rest >> 3;
    const int tok0 = b * SEQ + j * 64;
    float cum[16], kk[16], total, ref;
    bf16_t cf[16], cv[16];
#pragma unroll
    for (int i = 0; i < 16; ++i) { cf[i] = pf[i]; cv[i] = pv[i]; }
    if (u + (int)gridDim.x < 4096) HA_LOAD(u + (int)gridDim.x);
    __syncthreads();
    hgrn_prep(z, hg_lb, tok0, hh, dir, k, qq, tot, cum, kk, total, ref, cf);
    float kd[16], vv[16];
#pragma unroll
    for (int i = 0; i < 16; ++i) { kd[i] = kk[i] * __expf(total - cum[i]); vv[i] = bf2f(cv[i]); }
    pack16_store(KdT + k * H_TS + qq * 32, kd);
    pack16_store(VT + k * H_TS + qq * 32, vv);
    if (qq == 0) HD[(size_t)u * 128 + k] = __expf(total);
    __syncthreads();
    f32x4 acc[8];
#pragma unroll
    for (int m = 0; m < 8; ++m) acc[m] = (f32x4){0.f, 0.f, 0.f, 0.f};
#pragma unroll
    for (int ks = 0; ks < 2; ++ks) { const bf16x8 bv = *(const bf16x8*)(VT + (wid * 16 + fr) * H_TS + ks * 64 + fq * 16);
#pragma unroll
      for (int m = 0; m < 8; ++m) { const bf16x8 ak = *(const bf16x8*)(KdT + (m * 16 + fr) * H_TS + ks * 64 + fq * 16);
        acc[m] = __builtin_amdgcn_mfma_f32_16x16x32_bf16(ak, bv, acc[m], 0, 0, 0); } }
    bf16_t* sp = ST + (size_t)u * 16384 + (wid * 16 + fr) * 128 + 4 * fq;
#pragma unroll
    for (int m = 0; m < 8; ++m) { u32x2 w; w.x = cvtpk(acc[m][0], acc[m][1]); w.y = cvtpk(acc[m][2], acc[m][3]); *(u32x2*)(sp + m * 16) = w; }
  }
}
DEV void hgrn_stepB(bf16_t* __restrict__ ST, const float* __restrict__ HD) {
  for (int gid = blockIdx.x * NTHR + tidx(); gid < 32 * 4096; gid += gridDim.x * NTHR) {
    const int seq = gid >> 12, e = (gid & 4095) * 4, kq = e & 127, dir = seq & 1;
    float S0 = 0.f, S1 = 0.f, S2 = 0.f, S3 = 0.f;
    for (int s0 = 0; s0 < 128; s0 += 8) {
      u32x2 uu[8]; f32x4 dd[8];
#pragma unroll
      for (int i = 0; i < 8; ++i) { const int j = dir ? 127 - (s0 + i) : (s0 + i); const size_t un = (size_t)seq * 128 + j;
        uu[i] = *(const u32x2*)(ST + un * 16384 + e); dd[i] = *(const f32x4*)(HD + un * 128 + kq); }
#pragma unroll
      for (int i = 0; i < 8; ++i) { const int j = dir ? 127 - (s0 + i) : (s0 + i); const size_t un = (size_t)seq * 128 + j;
        u32x2 w; w.x = cvtpk(S0, S1); w.y = cvtpk(S2, S3); *(u32x2*)(ST + un * 16384 + e) = w;
        S0 = dd[i][0] * S0 + __uint_as_float(uu[i].x << 16); S1 = dd[i][1] * S1 + __uint_as_float(uu[i].x & 0xffff0000u);
        S2 = dd[i][2] * S2 + __uint_as_float(uu[i].y << 16); S3 = dd[i][3] * S3 + __uint_as_float(uu[i].y & 0xffff0000u); }
    }
  }
}
DEV void hgrn_stepC(char* lds, const bf16_t* __restrict__ z, const float* __restrict__ hg_lb, const float* __restrict__ hg_norm,
                    const bf16_t* __restrict__ ST, bf16_t* __restrict__ mix) {
  const int tid = tidx(), wid = tid >> 6, lane = tid & 63, fr = lane & 15, fq = lane >> 4, k = tid & 127, qq = tid >> 7;
  const int mt = wid & 3, chh = wid >> 2;
  char* Qd = lds; char* Kd = lds + 64 * H_RS; char* Qs = lds + 128 * H_RS;
  char* VT = lds + 192 * H_RS;
  char* Pm = VT + 128 * H_TS;
  float* tot = (float*)(Pm + 64 * H_TS);
  float* ssq = tot + 512;
  bf16_t pq[16], pv[16], pf0[16], pf1[16];
#define HC_LOAD(U) do { const int j_ = (U) & 127, h_ = ((U) >> 7) & 3, b_ = (U) >> 9; const bf16_t* zb_ = z + (size_t)(b_ * SEQ + j_ * 64 + qq * 16) * ZLD + h_ * 128 + k; \
    hgrn_load16(zb_, pq); hgrn_load16(zb_ + 512, pf0); hgrn_load16(zb_ + 1024, pf1); hgrn_load16(zb_ + 1536, pv); } while (0)
  { const int u0 = vblock(); if (u0 < 2048) HC_LOAD(u0); }
  for (int u = vblock(); u < 2048; u += gridDim.x) {
    const int j = u & 127, hh = (u >> 7) & 3, b = u >> 9;
    const int tok0 = b * SEQ + j * 64;
    bf16_t cq[16], cv[16], cf0[16], cf1[16];
#pragma unroll
    for (int i = 0; i < 16; ++i) { cq[i] = pq[i]; cv[i] = pv[i]; cf0[i] = pf0[i]; cf1[i] = pf1[i]; }
    if (u + (int)gridDim.x < 2048) HC_LOAD(u + (int)gridDim.x);
    f32x4 ao[4];
#pragma unroll
    for (int n = 0; n < 4; ++n) ao[n] = (f32x4){0.f, 0.f, 0.f, 0.f};
    for (int dir = 0; dir < 2; ++dir) {
      float cum[16], kk[16], total, ref;
      bf16_t cf[16];
#pragma unroll
      for (int i = 0; i < 16; ++i) cf[i] = dir ? cf1[i] : cf0[i];
      bf16x8 sfr[16];
      { const int un_ = ((b * 4 + hh) * 2 + dir) * 128 + j; const bf16_t* sp_ = ST + (size_t)un_ * 16384 + (size_t)(chh * 64 + fr) * 128 + fq * 8;
#pragma unroll
        for (int ks = 0; ks < 4; ++ks)
#pragma unroll
          for (int n = 0; n < 4; ++n) sfr[ks * 4 + n] = *(const bf16x8*)(sp_ + n * 16 * 128 + ks * 32); }
      __syncthreads();
      hgrn_prep(z, hg_lb, tok0, hh, dir, k, qq, tot, cum, kk, total, ref, cf);
#pragma unroll
      for (int i = 0; i < 16; ++i) { const int s = qq * 16 + i; const float qv = siluf_(bf2f(cq[i])) * 0.08838834764831845f;
        *(bf16_t*)(Qd + s * H_RS + k * 2) = f2bf(qv * __expf(cum[i] - ref));
        *(bf16_t*)(Kd + s * H_RS + k * 2) = f2bf(kk[i] * __expf(ref - cum[i]));
        *(bf16_t*)(Qs + s * H_RS + k * 2) = f2bf(qv * __expf(cum[i])); }
      if (dir == 0) { float vv[16];
#pragma unroll
        for (int i = 0; i < 16; ++i) vv[i] = bf2f(cv[i]);
        pack16_store(VT + k * H_TS + qq * 32, vv); }
      __syncthreads();
      f32x4 sc[2] = {(f32x4){0.f, 0.f, 0.f, 0.f}, (f32x4){0.f, 0.f, 0.f, 0.f}};
#pragma unroll
      for (int ks = 0; ks < 4; ++ks) { const bf16x8 qf = *(const bf16x8*)(Qd + (mt * 16 + fr) * H_RS + ks * 64 + fq * 16);
#pragma unroll
        for (int n = 0; n < 2; ++n) { const bf16x8 kf = *(const bf16x8*)(Kd + (chh * 32 + n * 16 + fr) * H_RS + ks * 64 + fq * 16);
          sc[n] = __builtin_amdgcn_mfma_f32_16x16x32_bf16(kf, qf, sc[n], 0, 0, 0); } }
      const int trow = mt * 16 + fr;
#pragma unroll
      for (int n = 0; n < 2; ++n) { float pv[4];
#pragma unroll
        for (int e = 0; e < 4; ++e) { const int s = chh * 32 + n * 16 + 4 * fq + e; const bool keep = dir == 0 ? (s <= trow) : (s >= trow); pv[e] = keep ? sc[n][e] : 0.f; }
        u32x2 w; w.x = cvtpk(pv[0], pv[1]); w.y = cvtpk(pv[2], pv[3]); *(u32x2*)(Pm + trow * H_TS + (chh * 32 + n * 16 + 4 * fq) * 2) = w; }
      const int un = ((b * 4 + hh) * 2 + dir) * 128 + j;
      const bf16_t* sp = ST + (size_t)un * 16384 + (size_t)(chh * 64 + fr) * 128 + fq * 8;
#pragma unroll
      for (int ks = 0; ks < 4; ++ks) { const bf16x8 qf = *(const bf16x8*)(Qs + (mt * 16 + fr) * H_RS + ks * 64 + fq * 16);
#pragma unroll
        for (int n = 0; n < 4; ++n) ao[n] = __builtin_amdgcn_mfma_f32_16x16x32_bf16(sfr[ks * 4 + n], qf, ao[n], 0, 0, 0); }
      __syncthreads();
#pragma unroll
      for (int ks = 0; ks < 2; ++ks) { const bf16x8 pf = *(const bf16x8*)(Pm + (mt * 16 + fr) * H_TS + ks * 64 + fq * 16);
#pragma unroll
        for (int n = 0; n < 4; ++n) { const bf16x8 vf = *(const bf16x8*)(VT + (chh * 64 + n * 16 + fr) * H_TS + ks * 64 + fq * 16);
          ao[n] = __builtin_amdgcn_mfma_f32_16x16x32_bf16(vf, pf, ao[n], 0, 0, 0); } }
    }
    float ss = 0.f;
#pragma unroll
    for (int n = 0; n < 4; ++n) ss += ao[n][0] * ao[n][0] + ao[n][1] * ao[n][1] + ao[n][2] * ao[n][2] + ao[n][3] * ao[n][3];
    ss += shfl_xor_f(ss, 16); ss += shfl_xor_f(ss, 32);
    if (fq == 0) ssq[chh * 64 + mt * 16 + fr] = ss;
    __syncthreads();
    const float rstd = rsqrtf((ssq[mt * 16 + fr] + ssq[64 + mt * 16 + fr]) * (1.f / 128.f) + EPS);
    const int tok = tok0 + mt * 16 + fr;
#pragma unroll
    for (int n = 0; n < 4; ++n) { const int v0 = chh * 64 + n * 16 + 4 * fq;
      const f32x4 gn = *(const f32x4*)(hg_norm + hh * 128 + v0);
      const u32x2 gz = *(const u32x2*)(z + (size_t)tok * ZLD + 2048 + hh * 128 + v0);
      const float g0 = siluf_(__uint_as_float(gz.x << 16)), g1 = siluf_(__uint_as_float(gz.x & 0xffff0000u)), g2 = siluf_(__uint_as_float(gz.y << 16)), g3 = siluf_(__uint_as_float(gz.y & 0xffff0000u));
      u32x2 w; w.x = cvtpk(ao[n][0] * rstd * gn[0] * g0, ao[n][1] * rstd * gn[1] * g1); w.y = cvtpk(ao[n][2] * rstd * gn[2] * g2, ao[n][3] * rstd * gn[3] * g3);
      *(u32x2*)(mix + (size_t)tok * DM + hh * 128 + v0) = w; }
  }
}

DEV void mla_phase(char* lds, const bf16_t* __restrict__ QF, const bf16_t* __restrict__ KVF, const bf16_t* __restrict__ Z, bf16_t* __restrict__ mix) {
  const int wid = tidx() >> 6, lane = tidx() & 63, r32 = lane & 31, hi = lane >> 5;
  for (int u = vblock(); u < 512; u += gridDim.x) {
    const int bh = u >> 5, qb = u & 31, b = bh >> 2, h = bh & 3;
    const size_t t0 = (size_t)b * SEQ;
    f32x16 o[4];
    attn_body_s<12, true>(QF + (t0 + qb * 256) * 768 + h * 192, 768, KVF + t0 * 1024 + h * 256, 1024, Z + t0 * ZLD + 3200, ZLD, KVF + t0 * 1024 + h * 256 + 128, 1024, SEQ, lds, o);
    bf16_t* op = mix + (t0 + qb * 256 + wid * 32) * DM + 512 + h * 128 + r32; asm volatile("" : "+v"(op));
#pragma unroll
    for (int r = 0; r < 16; ++r) { const int orow = crow(r, hi);
#pragma unroll
      for (int d0 = 0; d0 < 4; ++d0) op[(size_t)orow * DM + d0 * 32] = f2bf(o[d0][r]); }
  }
}
DEV void diff_phase(char* lds, const bf16_t* __restrict__ QKV, const Params& p, float* __restrict__ scr, bf16_t* __restrict__ mix) {
  const int wid = tidx() >> 6, lane = tidx() & 63, r32 = lane & 31, hi = lane >> 5;
  float d1 = p.lq1[lane] * p.lk1[lane], d2 = p.lq2[lane] * p.lk2[lane];
#pragma unroll
  for (int o = 32; o >= 1; o >>= 1) { d1 += shfl_xor_f(d1, o); d2 += shfl_xor_f(d2, o); }
  const float lam = __expf(d1) - __expf(d2) + LAMBDA_INIT;
  float* myscr = scr + (size_t)blockIdx.x * 32768 + wid * 4096 + lane;
  for (int u = vblock(); u < 1024; u += gridDim.x) {
    const int bh = u >> 5, qb = u & 31, b = bh >> 3, h = bh & 7;
    const size_t t0 = (size_t)b * SEQ;
    const bf16_t* base = QKV + t0 * 3072;
    f32x16 o[4];
#pragma unroll 1
    for (int c = 0; c < 2; ++c) {
      attn_body<4, true>(base + (size_t)(qb * 256) * 3072 + h * 128 + c * 64, 3072, nullptr, 0, base + 1024 + h * 128 + c * 64, 3072, base + 2048 + h * 128, 3072, SEQ, lds, o);
      if (c == 0) {
        float* wrscr = myscr; asm volatile("" : "+v"(wrscr));
#pragma unroll
        for (int d0 = 0; d0 < 4; ++d0)
#pragma unroll
          for (int r = 0; r < 16; ++r) wrscr[(d0 * 16 + r) * 64] = o[d0][r];
      }
    }
    float ss[16];
#pragma unroll
    for (int r = 0; r < 16; ++r) ss[r] = 0.f;
    const float* rdscr = myscr; asm volatile("" : "+v"(rdscr));
#pragma unroll
    for (int d0 = 0; d0 < 4; ++d0)
#pragma unroll
      for (int r = 0; r < 16; ++r) { const float v = rdscr[(d0 * 16 + r) * 64] - lam * o[d0][r]; o[d0][r] = v; ss[r] += v * v; }
#pragma unroll
    for (int r = 0; r < 16; ++r) {
#pragma unroll
      for (int s = 16; s >= 1; s >>= 1) ss[r] += shfl_xor_f(ss[r], s);
      ss[r] = rsqrtf(ss[r] * (1.f / 128.f) + EPS) * (1.f - LAMBDA_INIT); }
    bf16_t* op = mix + (t0 + qb * 256 + wid * 32) * DM + h * 128 + r32; asm volatile("" : "+v"(op));
#pragma unroll
    for (int d0 = 0; d0 < 4; ++d0) { const float gn = p.diff_norm[d0 * 32 + r32];
#pragma unroll
      for (int r = 0; r < 16; ++r) op[(size_t)crow(r, hi) * DM + d0 * 32] = f2bf(o[d0][r] * ss[r] * gn); }
  }
}


__global__ void __launch_bounds__(NTHR) fwd_megakernel(Params p) {
  extern __shared__ __attribute__((aligned(16))) char lds[];
  cg::grid_group grid = cg::this_grid();
  __shared__ __attribute__((aligned(16))) unsigned xb_words[4];
  if (threadIdx.x < 4) xb_words[threadIdx.x] = 0u;
  __syncthreads();
  (void)xcd_barrier_post((unsigned*)(p.ws + WS_BAR), (volatile LAS unsigned*)&xb_words[0]);
  unsigned char* ws = p.ws;
  bf16_t* W_in0 = (bf16_t*)(ws + WS_WIN0); bf16_t* W_uq = (bf16_t*)(ws + WS_WUQ); bf16_t* W_ukv = (bf16_t*)(ws + WS_WUKV); bf16_t* W_out0 = (bf16_t*)(ws + WS_WOUT0);
  bf16_t* W_gu = (bf16_t*)(ws + WS_WGU); bf16_t* W_dn = (bf16_t*)(ws + WS_WDN); bf16_t* W_cin = (bf16_t*)(ws + WS_WCIN); bf16_t* W_cout = (bf16_t*)(ws + WS_WCOUT);
  float* COS = (float*)(ws + WS_COS); float* SIN = (float*)(ws + WS_SIN); float* HD = (float*)(ws + WS_HD);
  bf16_t* HB = (bf16_t*)(ws + WS_HB); bf16_t* Z = (bf16_t*)(ws + WS_Z); bf16_t* CN = (bf16_t*)(ws + WS_CN); bf16_t* QF = (bf16_t*)(ws + WS_QF); bf16_t* KVF = (bf16_t*)(ws + WS_KVF);
  bf16_t* ST = (bf16_t*)p.out;
  float* SCR = (float*)(ws + WS_SCR);
  constexpr size_t WGU_E = (size_t)5632 * 1024, WDN_E = (size_t)1024 * 2816;

#define GSYNC() do { XcdBarrier xb_; xb_.bar = (unsigned*)(p.ws + WS_BAR); xb_.x = xb_xcc_id(); xb_.st = (volatile LAS unsigned*)&xb_words[0]; xcd_barrier(xb_); } while (0)
  {
    const int gtid = blockIdx.x * NTHR + tidx(), gsz = gridDim.x * NTHR;
    for (int i = gtid; i < SEQ * 32; i += gsz) { const int pos = i >> 5, jf = i & 31; const float ang = (float)pos * p.inv[jf];
      const double a = (double)ang; const double n = rint(a * 0.15915494309189535); const float r = (float)(a - n * 6.283185307179586);
      COS[i] = __cosf(r); SIN[i] = __sinf(r); }
    for (int i = gtid; i < 64 * 1024; i += gsz) W_in0[(size_t)3264 * 1024 + i] = 0;
    int xrot = 0;
    xpose_job(lds, p.ab_w_in, 1024, 3264, W_in0, 0, xrot);
    xpose_job(lds, p.w_uq, 384, 768, W_uq, 0, xrot);
    xpose_job(lds, p.w_ukv, 256, 1024, W_ukv, 0, xrot);
    xpose_job(lds, p.ab_w_out, 1024, 1024, W_out0, 0, xrot);
    for (int l = 0; l < 2; ++l) {
      xpose_job(lds, p.w_gate + (size_t)l * 1024 * FH, 1024, FH, W_gu + l * WGU_E, 1, xrot);
      xpose_job(lds, p.w_up + (size_t)l * 1024 * FH, 1024, FH, W_gu + l * WGU_E, 2, xrot);
      xpose_job(lds, p.w_down + (size_t)l * FH * 1024, FH, 1024, W_dn + l * WDN_E, 0, xrot);
    }
    xpose_job(lds, p.c_w_in, 1024, 3072, W_cin, 0, xrot);
    xpose_job(lds, p.c_w_out, 1024, 1024, W_cout, 0, xrot);
    rms_rows_bf16(p.x, p.norm_attn, HB);
  }
  asm volatile("s_waitcnt vmcnt(0)" ::: "memory"); grid.sync();
  { EpiStore e{Z, ZLD, 1, COS, SIN, 1}; gemm_phase<EpiStore, true>(lds, HB, 1024, W_in0, 1024, 1024, 13, 128 * 13, e); }
  GSYNC();
  cnorm_rows(Z, p.q_norm, p.kv_norm, CN);
  hgrn_stepA(lds, Z, p.hg_lb, ST, HD);
  GSYNC();
  hgrn_stepB(ST, HD);
  { EpiStore e{QF, 768, 2, COS, SIN, 1}; gemm_phase<EpiStore, true>(lds, CN, 640, W_uq, 384, 384, 3, 128 * 3, e); }
  { EpiStore e{KVF, 1024, 0, COS, SIN, 1}; gemm_phase<EpiStore, true>(lds, CN + 384, 640, W_ukv, 256, 256, 4, 128 * 4, e); }
  GSYNC();
  mla_phase(lds, QF, KVF, Z, HB);
  hgrn_stepC(lds, Z, p.hg_lb, p.hg_norm, ST, HB);
  GSYNC();
  { EpiResid e{p.x, p.out}; gemm_phase(lds, HB, 1024, W_out0, 1024, 1024, 4, 128 * 4, e); }
  GSYNC();
  for (int layer = 0; layer < 2; ++layer) {
    if (layer == 1) {
      rms_rows_bf16(p.out, p.norm_attn + 1024, HB);
      GSYNC();
      { EpiStore e{Z, 3072, 3, COS, SIN, 1}; gemm_phase<EpiStore, true>(lds, HB, 1024, W_cin, 1024, 1024, 12, 128 * 12, e); }
      GSYNC();
      diff_phase(lds, Z, p, SCR, HB);
      GSYNC();
      { EpiResid e{p.out, p.out}; gemm_phase(lds, HB, 1024, W_cout, 1024, 1024, 4, 128 * 4, e); }
      GSYNC();
    }
    rms_rows_bf16(p.out, p.norm_ffn + layer * 1024, HB);
    GSYNC();
    { EpiSwiglu e{Z}; gemm_phase<EpiSwiglu, true>(lds, HB, 1024, W_gu + layer * WGU_E, 1024, 1024, 22, 128 * 22, e); }
    GSYNC();
    { EpiResid e{p.out, p.out}; gemm_phase(lds, Z, FH, W_dn + layer * WDN_E, FH, FH, 4, 128 * 4, e); }
    GSYNC();
  }
  rms_rows_f32(p.out, p.final_norm);
}

extern "C" void kernel_launch(void* const* d_in, const int* in_sizes, int n_in, void* d_out, int out_size, void* d_ws, size_t ws_size, hipStream_t stream) {
  static int grid_blocks = 0;
  if (grid_blocks == 0) {
    if (n_in != 22 || out_size != T_TOK * DM || ws_size < WS_END) { fprintf(stderr, "kernel_launch: unexpected shapes n_in %d out %d ws %zu (need %zu)\n", n_in, out_size, ws_size, (size_t)WS_END); grid_blocks = -1; return; }
    int dev = 0, cus = 0, per_cu = 0;
    hipGetDevice(&dev);
    hipDeviceGetAttribute(&cus, hipDeviceAttributeMultiprocessorCount, dev);
    if (hipFuncSetAttribute((const void*)fwd_megakernel, hipFuncAttributeMaxDynamicSharedMemorySize, LDS_BYTES) != hipSuccess) { fprintf(stderr, "kernel_launch: hipFuncSetAttribute failed\n"); grid_blocks = -1; return; }
    if (hipOccupancyMaxActiveBlocksPerMultiprocessor(&per_cu, (const void*)fwd_megakernel, NTHR, LDS_BYTES) != hipSuccess || per_cu < 1) { fprintf(stderr, "kernel_launch: occupancy query gives %d\n", per_cu); per_cu = 1; }
    (void)hipGetLastError();
    grid_blocks = cus;
    if (grid_blocks % 8) grid_blocks -= grid_blocks % 8;
  }
  if (grid_blocks < 0) return;
  Params p{};
  const float** pf = (const float**)&p;
  for (int i = 0; i < 22; ++i) pf[i] = (const float*)d_in[i];
  p.out = (float*)d_out; p.ws = (unsigned char*)d_ws;
  for (int j = 0; j < 32; ++j) p.inv[j] = (float)(1.0 / pow(10000.0, (double)j / 32.0));
  if (hipMemsetAsync((char*)d_ws + WS_BAR, 0, XCD_BAR_WORDS * 4, stream) != hipSuccess) { fprintf(stderr, "kernel_launch: memset of the barrier words failed\n"); return; }
  void* args[] = {&p};
  hipError_t e = hipLaunchCooperativeKernel((const void*)fwd_megakernel, dim3(grid_blocks), dim3(NTHR), args, LDS_BYTES, stream);
  if (e != hipSuccess) fprintf(stderr, "kernel_launch: cooperative launch failed: %s (grid %d)\n", hipGetErrorString(e), grid_blocks);
}
```
